# Optimizing an MI355X kernel written in HIP

```python
import math
import jax
import jax.numpy as jnp
from jax import lax
import numpy as np


D_MODEL = 1024
BATCH = 16
SEQ = 4096
DEPTH = 4

MLA_HEADS = 8
MLA_Q_LORA = 256
MLA_KV_LORA = 128
MLA_NOPE = 64
MLA_ROPE = 32
MLA_V = 64
DIFF_HEADS = 8
DIFF_HEAD_DIM = 32
DIFF_ROT = DIFF_HEAD_DIM // 4
DIFF_QK = DIFF_HEADS * 2 * DIFF_HEAD_DIM
DIFF_V = DIFF_HEADS * 2 * DIFF_HEAD_DIM
SSM_GROUP = 16
SSM_GROUPS = 32
SSM_WIDTH = SSM_GROUP * SSM_GROUPS
SSM_STATE = 64
N_BRANCH = 3
IN_WIDTH = MLA_Q_LORA + MLA_KV_LORA + MLA_ROPE + 2 * DIFF_QK + DIFF_V + SSM_WIDTH + N_BRANCH * D_MODEL
ROPE_THETA = 500000.0
Q_BLOCK = 128
N_EXPERTS = 32
N_GROUPS = 8
EXPERTS_PER_GROUP = N_EXPERTS // N_GROUPS
TOP_K = 2
EXPERT_FF = 512
MOE_BLOCK = 128
DN_ALPHA = (2 * DEPTH) ** 0.25
DN_BETA = (8 * DEPTH) ** -0.25
LN_EPS = 1e-5
RMS_EPS = 1e-6

kernel_name = "hybrid_mla_diff_s5_moe_deepnorm"


def _rmsnorm(x, g, eps=RMS_EPS):
    xf = x.astype(jnp.float32)
    y = xf * lax.rsqrt(jnp.mean(xf * xf, axis=-1, keepdims=True) + eps)
    return (y * g.astype(jnp.float32)).astype(x.dtype)


def _layernorm(x, g, b):
    xf = x.astype(jnp.float32)
    mu = jnp.mean(xf, axis=-1, keepdims=True)
    xc = xf - mu
    var = jnp.mean(xc * xc, axis=-1, keepdims=True)
    y = xc * lax.rsqrt(var + LN_EPS) * g.astype(jnp.float32) + b.astype(jnp.float32)
    return y.astype(x.dtype)


def _rope_tables(positions, rot_dim):
    inv = ROPE_THETA ** (-jnp.arange(0, rot_dim, 2, dtype=jnp.float32) / rot_dim)
    ang = positions.astype(jnp.float32)[..., None] * inv
    return jnp.cos(ang)[:, :, None, :], jnp.sin(ang)[:, :, None, :]


def _apply_rope(x, cos, sin):
    half = cos.shape[-1]
    rot = 2 * half
    xf = x[..., :rot].astype(jnp.float32)
    x1, x2 = xf[..., :half], xf[..., half:]
    r = jnp.concatenate([x1 * cos - x2 * sin, x2 * cos + x1 * sin], axis=-1).astype(x.dtype)
    return jnp.concatenate([r, x[..., rot:]], axis=-1)


def _causal_attention(q, k, v, scale):
    B, S, H, dq = q.shape
    nb = S // Q_BLOCK
    qb = jnp.moveaxis(q.reshape(B, nb, Q_BLOCK, H, dq), 1, 0)
    kpos = jnp.arange(S)

    def block(args):
        qi, bi = args
        s = jnp.einsum('bqhd,bkhd->bhqk', qi, k, preferred_element_type=jnp.float32) * scale
        qpos = bi * Q_BLOCK + jnp.arange(Q_BLOCK)
        s = jnp.where(kpos[None, :] <= qpos[:, None], s, -1e30)
        p = jax.nn.softmax(s, axis=-1).astype(v.dtype)
        return jnp.einsum('bhqk,bkhd->bqhd', p, v)

    o = lax.map(block, (qb, jnp.arange(nb)))
    return jnp.moveaxis(o, 0, 1).reshape(B, S, H, v.shape[-1])


def _split_in(u):
    sizes = (MLA_Q_LORA, MLA_KV_LORA, MLA_ROPE, DIFF_QK, DIFF_QK, DIFF_V, SSM_WIDTH, N_BRANCH * D_MODEL)
    cuts = [int(c) for c in np.cumsum(sizes)[:-1]]
    return jnp.split(u, cuts, axis=-1)


def _mla_branch(c_q, c_kv, k_r, cos, sin, q_norm, w_uq, kv_norm, w_ukv, w_out):
    B, S, _ = c_q.shape
    q = (_rmsnorm(c_q, q_norm) @ w_uq).reshape(B, S, MLA_HEADS, MLA_NOPE + MLA_ROPE)
    q = jnp.concatenate([q[..., :MLA_NOPE], _apply_rope(q[..., MLA_NOPE:], cos, sin)], axis=-1)
    kv = (_rmsnorm(c_kv, kv_norm) @ w_ukv).reshape(B, S, MLA_HEADS, MLA_NOPE + MLA_V)
    k_nope, v = kv[..., :MLA_NOPE], kv[..., MLA_NOPE:]
    k_rope = _apply_rope(k_r[:, :, None, :], cos, sin)
    k = jnp.concatenate([k_nope, jnp.broadcast_to(k_rope, (B, S, MLA_HEADS, MLA_ROPE))], axis=-1)
    o = _causal_attention(q, k, v, (MLA_NOPE + MLA_ROPE) ** -0.5)
    return o.reshape(B, S, MLA_HEADS * MLA_V) @ w_out


def _diff_branch(q, k, v, cos, sin, lam, subln, w_out, lambda_init):
    B, S, _ = q.shape
    q = q.reshape(B, S, DIFF_HEADS, 2, DIFF_HEAD_DIM)
    k = k.reshape(B, S, DIFF_HEADS, 2, DIFF_HEAD_DIM)
    v = v.reshape(B, S, DIFF_HEADS, 2 * DIFF_HEAD_DIM)
    q1, q2 = _apply_rope(q[:, :, :, 0], cos, sin), _apply_rope(q[:, :, :, 1], cos, sin)
    k1, k2 = _apply_rope(k[:, :, :, 0], cos, sin), _apply_rope(k[:, :, :, 1], cos, sin)
    lf = lam.astype(jnp.float32)
    lam_val = jnp.exp(jnp.sum(lf[0] * lf[1])) - jnp.exp(jnp.sum(lf[2] * lf[3])) + lambda_init
    scale = DIFF_HEAD_DIM ** -0.5
    o = _causal_attention(q1, k1, v, scale) - lam_val.astype(v.dtype) * _causal_attention(q2, k2, v, scale)
    o = _rmsnorm(o, subln, 1e-5) * (1.0 - lambda_init)
    return o.reshape(B, S, DIFF_V) @ w_out


def _ssm_branch(u, a_re, a_im, log_dt, b_re, b_im, c_re, c_im, d, w_glu):
    B, S, _ = u.shape
    uf = u.astype(jnp.float32).reshape(B, S, SSM_GROUPS, SSM_GROUP)
    A = lax.complex(a_re.astype(jnp.float32), a_im.astype(jnp.float32))
    dt = jnp.exp(log_dt.astype(jnp.float32))[:, None]
    a_bar = jnp.exp(A * dt)
    b_bar = ((a_bar - 1.0) / A)[..., None] * lax.complex(b_re.astype(jnp.float32), b_im.astype(jnp.float32))
    bu = jnp.einsum('bsgp,gnp->sbgn', uf.astype(jnp.complex64), b_bar)
    a_seq = jnp.broadcast_to(a_bar[None, None], (S, 1, SSM_GROUPS, SSM_STATE))

    def combine(left, right):
        a_l, b_l = left
        a_r, b_r = right
        return a_r * a_l, a_r * b_l + b_r

    _, h = lax.associative_scan(combine, (a_seq, bu), axis=0)
    C = lax.complex(c_re.astype(jnp.float32), c_im.astype(jnp.float32))
    y = jnp.real(jnp.einsum('sbgn,gpn->bsgp', h, C)) + d.astype(jnp.float32).reshape(SSM_GROUPS, SSM_GROUP) * uf
    y = jax.nn.gelu(y.reshape(B, S, SSM_WIDTH)).astype(u.dtype)
    gl = y @ w_glu
    return gl[..., :D_MODEL] * jax.nn.sigmoid(gl[..., D_MODEL:])


def _moe(x, router_w, router_bias, w_gate, w_up, w_down):
    B, S, D = x.shape
    T = B * S
    xt = x.reshape(T, D)
    scores = jax.nn.sigmoid((xt @ router_w).astype(jnp.float32))
    biased = scores + router_bias.astype(jnp.float32)
    grouped = biased.reshape(T, N_GROUPS, EXPERTS_PER_GROUP)
    group_score = jnp.sum(lax.top_k(grouped, TOP_K)[0], axis=-1)
    g_sel = jnp.argmax(group_score, axis=-1)
    in_group = jnp.take_along_axis(grouped, g_sel[:, None, None], axis=1)[:, 0]
    _, loc = lax.top_k(in_group, TOP_K)
    idx = g_sel[:, None] * EXPERTS_PER_GROUP + loc
    w = jnp.take_along_axis(scores, idx, axis=1)
    w = w / jnp.sum(w, axis=-1, keepdims=True)
    A = T * TOP_K
    e_flat = idx.reshape(A)
    tok_flat = jnp.arange(A, dtype=jnp.int32) // TOP_K
    order = jnp.argsort(e_flat)
    e_sorted, tok_sorted, w_sorted = e_flat[order], tok_flat[order], w.reshape(A)[order]
    counts = jnp.zeros((N_EXPERTS,), jnp.int32).at[e_flat].add(1)
    starts = jnp.cumsum(counts) - counts
    padded = (counts + MOE_BLOCK - 1) // MOE_BLOCK * MOE_BLOCK
    pad_ends = jnp.cumsum(padded)
    pad_starts = pad_ends - padded
    dest = pad_starts[e_sorted] + jnp.arange(A, dtype=jnp.int32) - starts[e_sorted]
    n_blocks = -(-A // MOE_BLOCK) + N_EXPERTS
    R = n_blocks * MOE_BLOCK
    row_tok = jnp.full((R,), T, jnp.int32).at[dest].set(tok_sorted)
    row_w = jnp.zeros((R,), jnp.float32).at[dest].set(w_sorted)
    block_e = jnp.minimum(jnp.searchsorted(pad_ends, jnp.arange(n_blocks, dtype=jnp.int32) * MOE_BLOCK, side='right'), N_EXPERTS - 1)
    x_pad = jnp.concatenate([xt, jnp.zeros((1, D), xt.dtype)], axis=0)
    xb = x_pad[row_tok].reshape(n_blocks, MOE_BLOCK, D)

    def expert_block(args):
        xi, e = args
        hdn = jax.nn.silu(xi @ w_gate[e]) * (xi @ w_up[e])
        return hdn @ w_down[e]

    yb = lax.map(expert_block, (xb, block_e)).reshape(R, D)
    y = jnp.zeros((T + 1, D), jnp.float32).at[row_tok].add(yb.astype(jnp.float32) * row_w[:, None])[:T]
    return y.astype(x.dtype).reshape(B, S, D)


def setup_inputs(seed: int = 0) -> dict:
    key = jax.random.key(seed)
    keys = jax.random.split(key, 40)
    counter = [0]

    def nxt():
        counter[0] += 1
        return keys[counter[0] - 1]

    def nrm(shape, scale):
        return jax.random.normal(nxt(), shape, jnp.float32) * scale

    L = DEPTH
    x = nrm((BATCH, SEQ, D_MODEL), 1.0)
    positions = (jax.random.randint(nxt(), (BATCH, 1), 0, 1024) + jnp.arange(SEQ)[None, :]).astype(jnp.int32)
    w_in = nrm((L, D_MODEL, IN_WIDTH), D_MODEL ** -0.5)
    b_gate = nrm((L, N_BRANCH, D_MODEL), 0.01)
    mla_q_norm = 1.0 + nrm((L, MLA_Q_LORA), 0.01)
    mla_w_uq = nrm((L, MLA_Q_LORA, MLA_HEADS * (MLA_NOPE + MLA_ROPE)), MLA_Q_LORA ** -0.5)
    mla_kv_norm = 1.0 + nrm((L, MLA_KV_LORA), 0.01)
    mla_w_ukv = nrm((L, MLA_KV_LORA, MLA_HEADS * (MLA_NOPE + MLA_V)), MLA_KV_LORA ** -0.5)
    mla_w_out = nrm((L, MLA_HEADS * MLA_V, D_MODEL), (MLA_HEADS * MLA_V) ** -0.5)
    diff_lambda = nrm((L, 4, DIFF_HEAD_DIM), 0.1)
    diff_subln = 1.0 + nrm((L, 2 * DIFF_HEAD_DIM), 0.01)
    diff_w_out = nrm((L, DIFF_V, D_MODEL), DIFF_V ** -0.5)
    ssm_a_re = -0.5 + nrm((L, SSM_GROUPS, SSM_STATE), 0.01)
    ssm_a_im = jnp.pi * jnp.arange(SSM_STATE, dtype=jnp.float32) + nrm((L, SSM_GROUPS, SSM_STATE), 0.01)
    ssm_log_dt = jax.random.uniform(nxt(), (L, SSM_GROUPS), jnp.float32, math.log(1e-3), math.log(1e-1))
    ssm_b_re = nrm((L, SSM_GROUPS, SSM_STATE, SSM_GROUP), (2 * SSM_GROUP) ** -0.5)
    ssm_b_im = nrm((L, SSM_GROUPS, SSM_STATE, SSM_GROUP), (2 * SSM_GROUP) ** -0.5)
    ssm_c_re = nrm((L, SSM_GROUPS, SSM_GROUP, SSM_STATE), (2 * SSM_STATE) ** -0.5)
    ssm_c_im = nrm((L, SSM_GROUPS, SSM_GROUP, SSM_STATE), (2 * SSM_STATE) ** -0.5)
    ssm_d = nrm((L, SSM_WIDTH), 1.0)
    ssm_w_glu = nrm((L, SSM_WIDTH, 2 * D_MODEL), SSM_WIDTH ** -0.5)
    w_o = nrm((L, D_MODEL, D_MODEL), D_MODEL ** -0.5 * DN_BETA)
    ln_gain = 1.0 + nrm((L, 2, D_MODEL), 0.01)
    ln_bias = nrm((L, 2, D_MODEL), 0.01)
    router_w = nrm((D_MODEL, N_EXPERTS), D_MODEL ** -0.5)
    router_bias = nrm((N_EXPERTS,), 0.01)
    moe_w_gate = nrm((L, N_EXPERTS, D_MODEL, EXPERT_FF), D_MODEL ** -0.5)
    moe_w_up = nrm((L, N_EXPERTS, D_MODEL, EXPERT_FF), D_MODEL ** -0.5)
    moe_w_down = nrm((L, N_EXPERTS, EXPERT_FF, D_MODEL), EXPERT_FF ** -0.5 * DN_BETA)
    return {"x": x, "positions": positions, "w_in": w_in, "b_gate": b_gate,
            "mla_q_norm": mla_q_norm, "mla_w_uq": mla_w_uq, "mla_kv_norm": mla_kv_norm,
            "mla_w_ukv": mla_w_ukv, "mla_w_out": mla_w_out, "diff_lambda": diff_lambda,
            "diff_subln": diff_subln, "diff_w_out": diff_w_out, "ssm_a_re": ssm_a_re,
            "ssm_a_im": ssm_a_im, "ssm_log_dt": ssm_log_dt, "ssm_b_re": ssm_b_re,
            "ssm_b_im": ssm_b_im, "ssm_c_re": ssm_c_re, "ssm_c_im": ssm_c_im, "ssm_d": ssm_d,
            "ssm_w_glu": ssm_w_glu, "w_o": w_o, "ln_gain": ln_gain, "ln_bias": ln_bias,
            "router_w": router_w, "router_bias": router_bias, "moe_w_gate": moe_w_gate,
            "moe_w_up": moe_w_up, "moe_w_down": moe_w_down}


def reference(x, positions, w_in, b_gate, mla_q_norm, mla_w_uq, mla_kv_norm, mla_w_ukv, mla_w_out,
              diff_lambda, diff_subln, diff_w_out, ssm_a_re, ssm_a_im, ssm_log_dt, ssm_b_re, ssm_b_im,
              ssm_c_re, ssm_c_im, ssm_d, ssm_w_glu, w_o, ln_gain, ln_bias, router_w, router_bias,
              moe_w_gate, moe_w_up, moe_w_down):
    B, S, _ = x.shape
    cos_a, sin_a = _rope_tables(positions, MLA_ROPE)
    cos_b, sin_b = _rope_tables(positions, DIFF_ROT)
    for l in range(DEPTH):
        u = x @ w_in[l]
        c_q, c_kv, k_r, q_d, k_d, v_d, u_s, g_logit = _split_in(u)
        y_a = _mla_branch(c_q, c_kv, k_r, cos_a, sin_a, mla_q_norm[l], mla_w_uq[l],
                          mla_kv_norm[l], mla_w_ukv[l], mla_w_out[l])
        lambda_init = 0.8 - 0.6 * math.exp(-0.3 * l)
        y_b = _diff_branch(q_d, k_d, v_d, cos_b, sin_b, diff_lambda[l], diff_subln[l],
                           diff_w_out[l], lambda_init)
        y_c = _ssm_branch(u_s, ssm_a_re[l], ssm_a_im[l], ssm_log_dt[l], ssm_b_re[l], ssm_b_im[l],
                          ssm_c_re[l], ssm_c_im[l], ssm_d[l], ssm_w_glu[l])
        gates = jax.nn.sigmoid((g_logit.reshape(B, S, N_BRANCH, D_MODEL) + b_gate[l]).astype(jnp.float32)).astype(x.dtype)
        merged = gates[:, :, 0] * y_a + gates[:, :, 1] * y_b + gates[:, :, 2] * y_c
        x = _layernorm(DN_ALPHA * x + merged @ w_o[l], ln_gain[l, 0], ln_bias[l, 0])
        x = _layernorm(DN_ALPHA * x + _moe(x, router_w, router_bias, moe_w_gate[l], moe_w_up[l], moe_w_down[l]),
                       ln_gain[l, 1], ln_bias[l, 1])
    return x
```

```cpp
#include <hip/hip_runtime.h>
#include <cstdio>
#include <cstdint>

#define GAS __attribute__((address_space(1)))
#define LAS __attribute__((address_space(3)))
typedef unsigned short bf16;
typedef unsigned char uchar;
typedef short bf16x8 __attribute__((ext_vector_type(8)));
typedef short s16x4 __attribute__((ext_vector_type(4)));
typedef float f32x2 __attribute__((ext_vector_type(2)));
typedef float f32x4 __attribute__((ext_vector_type(4)));
typedef float f32x16 __attribute__((ext_vector_type(16)));
typedef unsigned u32x4 __attribute__((ext_vector_type(4)));
typedef unsigned u32x2 __attribute__((ext_vector_type(2)));

constexpr int D_MODEL = 1024, BATCH = 16, SEQ = 4096, DEPTH = 4, T = BATCH * SEQ;
constexpr int IN_WIDTH = 5536;
constexpr int N_EXP = 32, EXP_FF = 512;
constexpr int NASSIGN = 2 * T;
constexpr int RMAX = NASSIGN + N_EXP * 256;
constexpr float LN_EPS = 1e-5f, RMS_EPS = 1e-6f;
constexpr float DN_ALPHA = 1.6817928305074292f;
constexpr float LOG2E = 1.4426950408889634f;
constexpr int NCHUNK = T / 16;
constexpr int UC_LD = 384;
constexpr int U1_LD = 2048, O3_LD = 1536, G_LD = 3072, KV_LD = 1056;

constexpr size_t MiB = 1u << 20;
constexpr size_t WS_CTL = 0, WS_ZERO_BYTES = 1 * MiB;
constexpr size_t WS_SSQ = 1 * MiB;
constexpr size_t WS_ROPEA = 4 * MiB;
constexpr size_t WS_ROPEB = 12 * MiB;
constexpr size_t WS_TOKE = 14 * MiB;
constexpr size_t WS_TOKW = 14 * MiB + 512 * 1024;
constexpr size_t WS_TOKP = 15 * MiB;
constexpr size_t WS_SLOT = 15 * MiB + 512 * 1024;
constexpr size_t WS_ROWTOK = 986 * MiB;
constexpr int ECAP = 65536;
constexpr size_t WS_A16 = 17 * MiB;
constexpr size_t WS_RWH = 17 * MiB + 64 * 1024, WS_RWL = 17 * MiB + 128 * 1024;
constexpr size_t WS_WTS = 18 * MiB;
constexpr size_t W_IN = WS_WTS;
constexpr size_t W_G = W_IN + 5 * MiB;
constexpr size_t W_UQ = W_G + 6 * MiB;
constexpr size_t W_UKV = W_UQ + 384 * 1024;
constexpr size_t W_A = W_UKV + 512 * 1024;
constexpr size_t W_B = W_A + 1 * MiB;
constexpr size_t W_GLU = W_B + 1 * MiB;
constexpr size_t W_O = W_GLU + 2 * MiB;
constexpr size_t W_SS = W_O + 2 * MiB;
constexpr size_t W_SY = W_SS + 4 * MiB;
static_assert(W_SY + 6 * MiB <= 46 * MiB, "wts");
constexpr size_t WS_XB = 46 * MiB;
constexpr size_t WS_U1 = 174 * MiB;
constexpr size_t WS_Q = 430 * MiB;
constexpr size_t WS_KV = 526 * MiB;
constexpr size_t WS_UC = 658 * MiB;
constexpr size_t WS_O3 = 754 * MiB;
constexpr size_t WS_MG = 366 * MiB;
constexpr size_t WS_END = 1154 * MiB;
constexpr size_t W_GLU2 = 978 * MiB;
constexpr size_t WS_XRS = 982 * MiB;
constexpr size_t WS_GCS = 982 * MiB + 512 * 1024;
constexpr size_t WS_ICS = 982 * MiB + 768 * 1024;
constexpr size_t WS_XQ1 = 994 * MiB, WS_XQ2 = 1106 * MiB;
constexpr int XQ_SPLIT = 64;
constexpr int XQ_VOFF = (int)((WS_XQ2 - WS_XQ1) / 1024) - XQ_SPLIT * 256;
constexpr size_t WS_MCM = 512 * 1024;
constexpr size_t WS_G = WS_U1;
constexpr size_t WS_S = 946 * MiB;
constexpr size_t WS_Z = WS_O3;
constexpr size_t WS_H = WS_U1;
constexpr size_t WS_YB = WS_U1 + 136 * MiB;
constexpr size_t WS_WM1 = 1010 * MiB;
constexpr size_t WS_WM2 = 1074 * MiB;
static_assert((size_t)RMAX * 512 * 2 <= 136 * MiB && WS_YB + (size_t)RMAX * 1024 * 2 <= WS_UC && WS_G + (size_t)T * 3072 <= WS_MG && WS_MG + (size_t)T * 1024 * 2 <= WS_KV && WS_S + (64u << 20) <= WS_WM1, "workspace overlays");
constexpr int CW_BAR = 4096;
constexpr int CW_CNT = 2048;

constexpr int RING_BYTES = 131072;
constexpr int MISC_OFF = RING_BYTES;
constexpr int LDS_BYTES = 147456;
constexpr int MO_BAR = 0, MO_HIST = 64, MO_BASE = 192, MO_MTS = 320, MO_PADS = 512, MO_LAM = 704, MO_RSCR = 1024  , MO_PE = 5120, MO_PR = 7168, MO_PTAB = 9216;

#define LDS_WAIT() asm volatile("s_waitcnt lgkmcnt(0)" ::: "memory")
#define VM_WAIT() asm volatile("s_waitcnt vmcnt(0)" ::: "memory")
__device__ __forceinline__ unsigned f2bf(float f) { unsigned u = __builtin_bit_cast(unsigned, f); return (u + 0x7fffu + ((u >> 16) & 1u)) >> 16; }
__device__ __forceinline__ unsigned pk2(float lo, float hi) { return f2bf(lo) | (f2bf(hi) << 16); }
typedef __bf16 bf16x2_t __attribute__((ext_vector_type(2)));
__device__ __forceinline__ unsigned cvt_pk_bf16(float lo, float hi) { const f32x2 v = {lo, hi}; const bf16x2_t b = __builtin_convertvector(v, bf16x2_t); return __builtin_bit_cast(unsigned, b); }
__device__ __forceinline__ float bflo(unsigned w) { return __uint_as_float(w << 16); }
__device__ __forceinline__ float bfhi(unsigned w) { return __uint_as_float(w & 0xffff0000u); }
__device__ __forceinline__ float fast_sigmoid(float x) { return __builtin_amdgcn_rcpf(1.0f + __builtin_amdgcn_exp2f(-x * LOG2E)); }
__device__ __forceinline__ int ltid() { int t = threadIdx.x; asm volatile("" : "+v"(t)); return t; }
__device__ __forceinline__ float wave_max(float v) {
#pragma unroll
    for (int o = 1; o < 64; o <<= 1) v = fmaxf(v, __shfl_xor(v, o));
    return v;
}
__device__ __forceinline__ unsigned pack4_i8(float a, float b, float c, float d) { unsigned w = 0u;
    w = __builtin_amdgcn_cvt_pk_u8_f32(a + 128.0f, 0, w); w = __builtin_amdgcn_cvt_pk_u8_f32(b + 128.0f, 1, w); w = __builtin_amdgcn_cvt_pk_u8_f32(c + 128.0f, 2, w); w = __builtin_amdgcn_cvt_pk_u8_f32(d + 128.0f, 3, w);
    return w ^ 0x80808080u; }
__device__ __forceinline__ float wave_sum(float v) {
#pragma unroll
    for (int o = 1; o < 64; o <<= 1) v += __shfl_xor(v, o);
    return v;
}

#define XB_TMO      128
#define XB_XCNT(j)  (256  + 64 * (j))
#define XB_XSUB(j)  (1280 + 64 * (j))
#define XB_XGEN(j)  (2304 + 64 * (j))
#define XB_TOP      3328
#define XB_TOPGEN   3392
#define XCD_BAR_WORDS 3456
#define XB_SPIN_CAP (1u << 18)
__device__ __forceinline__ unsigned xb_ld(unsigned* p)              { return __hip_atomic_load(p, __ATOMIC_RELAXED, __HIP_MEMORY_SCOPE_AGENT); }
__device__ __forceinline__ unsigned xb_add(unsigned* p, unsigned v) { return __hip_atomic_fetch_add(p, v, __ATOMIC_RELAXED, __HIP_MEMORY_SCOPE_AGENT); }
__device__ __forceinline__ unsigned xb_xcc_id() { return (unsigned)__builtin_amdgcn_s_getreg((3 << 11) | 20) & 0xFu; }
#define XB_SPIN(cond, bar) do { unsigned _sp = 0; while (cond) { __builtin_amdgcn_s_sleep(1); \
    if ((++_sp & 255u) == 0u) { if (xb_ld(&(bar)[XB_TMO])) break; if (_sp > XB_SPIN_CAP) { atomicAdd(&(bar)[XB_TMO], 1u); break; } } } } while (0)
struct XcdBarrier { unsigned* bar; unsigned x; volatile LAS unsigned* st; };
__device__ __forceinline__ XcdBarrier xcd_barrier_post(unsigned* bar, volatile LAS unsigned* st) {
    XcdBarrier b; b.bar = nullptr; b.x = 0; b.st = st;
    const unsigned x = xb_xcc_id();
    if (threadIdx.x == 0) { (void)xb_add(&bar[XB_XCNT(x)], 1u); st[2] = x; st[4] = (unsigned)(unsigned long long)bar; st[5] = (unsigned)((unsigned long long)bar >> 32); }
    return b;
}
__device__ __forceinline__ void xcd_barrier_complete(unsigned* bar, unsigned x, unsigned& nloc, unsigned& nx) {
    const unsigned G = gridDim.x * gridDim.y * gridDim.z;
    unsigned sum, cnt, mine, sp = 0u;
    for (;;) {
        sum = 0u; cnt = 0u; mine = 0u;
#pragma unroll
        for (unsigned j = 0; j < 16; ++j) { const unsigned c = xb_ld(&bar[XB_XCNT(j)]); sum += c; cnt += (c > 0u) ? 1u : 0u; mine = (j == x) ? c : mine; }
        if (sum == G) break;
        __builtin_amdgcn_s_sleep(1);
        if ((++sp & 255u) == 0u) { if (xb_ld(&bar[XB_TMO])) break; if (sp > XB_SPIN_CAP) { atomicAdd(&bar[XB_TMO], 1u); break; } }
    }
    nloc = mine > 0u ? mine : 1u; nx = cnt > 0u ? cnt : 1u;
}
__device__ __forceinline__ void xcd_barrier(const XcdBarrier& b) {
    asm volatile("s_waitcnt vmcnt(0)" ::: "memory");
    __syncthreads();
    if (threadIdx.x == 0) {
        __builtin_amdgcn_s_waitcnt(0);
        unsigned* bar = (unsigned*)(((unsigned long long)b.st[5] << 32) | (unsigned long long)b.st[4]); const unsigned bx_ = b.st[2];
        unsigned nloc = b.st[0], nx = b.st[1];
        if (nloc == 0u) { xcd_barrier_complete(bar, bx_, nloc, nx); b.st[0] = nloc; b.st[1] = nx; }
        const unsigned old = xb_add(&bar[XB_XSUB(bx_)], 1u);
        const unsigned gen = old / nloc;
        if (old + 1u == (gen + 1u) * nloc) {
            __builtin_amdgcn_fence(__ATOMIC_RELEASE, "agent");
            asm volatile("s_waitcnt vmcnt(0)" ::: "memory");
            const unsigned og = xb_add(&bar[XB_TOP], 1u);
            const unsigned tg = og / nx;
            if (og + 1u == (tg + 1u) * nx) xb_add(&bar[XB_TOPGEN], 1u);
            else XB_SPIN(xb_ld(&bar[XB_TOPGEN]) == tg, bar);
            __builtin_amdgcn_fence(__ATOMIC_ACQUIRE, "agent");
            xb_add(&bar[XB_XGEN(bx_)], 1u);
            asm volatile("s_waitcnt vmcnt(0)" ::: "memory");
        } else {
            XB_SPIN(xb_ld(&bar[XB_XGEN(bx_)]) == gen, bar);
            __builtin_amdgcn_fence(__ATOMIC_ACQUIRE, "agent");
            asm volatile("s_waitcnt vmcnt(0)" ::: "memory");
        }
    }
    __syncthreads();
}

struct Args { const void* in[29]; float* out; uchar* ws; };
typedef const LAS unsigned long long* PT;
__device__ __forceinline__ const void* ldptr(PT pt, int k) { const unsigned long long v = pt[k]; const unsigned lo = __builtin_amdgcn_readfirstlane((unsigned)v), hi = __builtin_amdgcn_readfirstlane((unsigned)(v >> 32)); return (const void*)(const GAS void*)(((unsigned long long)hi << 32) | lo); }
enum { I_X = 0, I_POS, I_WIN, I_BGATE, I_QNORM, I_WUQ, I_KVNORM, I_WUKV, I_WAOUT, I_LAMBDA, I_SUBLN, I_WBOUT, I_ARE, I_AIM, I_LOGDT, I_BRE, I_BIM, I_CRE, I_CIM, I_SSMD, I_WGLU, I_WO, I_LNG, I_LNB, I_RW, I_RB, I_MG, I_MU, I_MD, I_OUT, I_WS };


namespace pg8 {
constexpr int BM = 256, BK = 64, HALF = 128, HTB = HALF * BK * 2, STAGE_BYTES = 8 * HTB, NXCD = 8, WGM = 8;
__host__ __device__ __forceinline__ int lds_byte(int r, int c) { const int st = (r >> 4) * 2 + (c >> 5), rr = r & 15, cc = c & 31, ob = rr * 64 + cc * 2; return st * 1024 + (ob ^ (((ob >> 9) & 1) << 5)); }
__host__ __device__ __forceinline__ void stage_rc(int b, int& R, int& C) { const int st = b / 1024, sb = b % 1024, swz = sb ^ (((sb >> 9) & 1) << 5); R = (st >> 1) * 16 + swz / 64; C = (st & 1) * 32 + (swz % 64) / 2; }
__host__ __device__ __forceinline__ int perm32(int rho) { const int n = rho >> 4, i = rho & 15; return 8 * (i >> 2) + 4 * n + (i & 3); }

struct Unit { const char* A; const char* B; const int* rows; int r0, c0, aux, kt; };

struct GridSched {
    int nM, nN, nwg, G, c, b_div; const char* Ab; const char* Bb; size_t a_step, bn_step, bg_step; int c_step;
    __device__ __forceinline__ void init(int nM_, int nN_, int G_, int c_, const void* A, size_t a_step_, const void* B, size_t bn_step_, int b_div_ = 1 << 30, size_t bg_step_ = 0, int c_step_ = 256) {
        nM = nM_; nN = nN_; nwg = nM * nN; G = G_; c = c_; Ab = (const char*)A; a_step = a_step_; Bb = (const char*)B; bn_step = bn_step_; b_div = b_div_; bg_step = bg_step_; c_step = c_step_; }
    __device__ __forceinline__ bool next(int i, Unit& u) const {
        const long L = (long)i * G + c; if (L >= nwg) return false;
        int wgid = (int)L; { const int q = nwg / NXCD, r = nwg % NXCD, xcd = wgid % NXCD, off = wgid / NXCD; wgid = (xcd < r ? xcd * (q + 1) : r * (q + 1) + (xcd - r) * q) + off; }
        const int nig = WGM * nN, gid = wgid / nig, fm = gid * WGM, gsz = (nM - fm) < WGM ? (nM - fm) : WGM;
        const int pm = fm + ((wgid % nig) % gsz), pn = (wgid % nig) / gsz;
        u.A = Ab + (size_t)pm * a_step; u.B = Bb + (size_t)pn * bn_step + (size_t)(pm / b_div) * bg_step; u.rows = nullptr; u.r0 = pm * BM; u.c0 = pn * c_step; u.aux = pn; return true;
    }
};

struct PairSched { GridSched base; long a_off, b_off;
    __device__ __forceinline__ bool next(int j, Unit& u) const { if (!base.next(j >> 1, u)) return false; if (j & 1) { u.A += a_off; u.B += b_off; } u.aux = j & 1; return true; } };

typedef int i32x4 __attribute__((ext_vector_type(4)));
template <bool I8> __device__ __forceinline__ f32x4 mma_sel(const bf16x8& b, const bf16x8& a, const f32x4& c) {
    if constexpr (I8) return __builtin_bit_cast(f32x4, __builtin_amdgcn_mfma_i32_16x16x64_i8(__builtin_bit_cast(i32x4, b), __builtin_bit_cast(i32x4, a), __builtin_bit_cast(i32x4, c), 0, 0, 0));
    else return __builtin_amdgcn_mfma_f32_16x16x32_bf16(b, a, c, 0, 0, 0);
}
struct SplitSched { GridSched base; const char* A2; int split; size_t a_step;
    __device__ __forceinline__ bool next(int i, Unit& u) const { if (!base.next(i, u)) return false; const int pm = u.r0 >> 8; if (pm >= split) u.A = A2 + (size_t)(pm - split) * a_step; return true; } };
struct TriSched { GridSched base; const char* Bglu;
    __device__ __forceinline__ bool next(int j, Unit& u) const { const int tile = j / 3, k = j - 3 * tile; if (!base.next(tile, u)) return false; const int pn = u.aux;
        if (k < 2) { u.A += 1024 * 2; u.B = Bglu + (size_t)(2 * pn + k) * (256 * 1024 * 2); u.c0 = (2 * pn + k) * 128; u.kt = 8; } else u.kt = 16;
        u.aux = k; return true; } };

#define PG8_SA(b, h) (((b) * 2 + (h)) * HTB)
#define PG8_SB(b, h) ((4 + (b) * 2 + (h)) * HTB)
#define PG8_STAGE_B(bufoff, gbase) do { const char* _g = (const char*)(gbase); asm volatile("" : "+s"(_g)); _Pragma("unroll") for (int _i = 0; _i < 2; ++_i) \
        __builtin_amdgcn_global_load_lds((const unsigned*)(_g + voffB[_i]), (LAS unsigned*)(lds + (bufoff) + ldsw + _i * 8192), 16, 0, 0); } while (0)
#define PG8_STAGE_A(bufoff, gbase, vo, h) do { const char* _g = (const char*)(gbase); asm volatile("" : "+s"(_g)); _Pragma("unroll") for (int _i = 0; _i < 2; ++_i) \
        __builtin_amdgcn_global_load_lds((const unsigned*)(_g + (vo)[h][_i]), (LAS unsigned*)(lds + (bufoff) + ldsw + _i * 8192), 16, 0, 0); } while (0)
#define PG8_LDA(dst, b, h) do { _Pragma("unroll") for (int m = 0; m < 4; ++m) _Pragma("unroll") for (int k = 0; k < 2; ++k) dst[m][k] = *(const LAS bf16x8*)(lds + PG8_SA(b, h) + aoff + m * 2048 + k * 1024); } while (0)
#define PG8_LDB(dst, b, h) do { _Pragma("unroll") for (int n = 0; n < 2; ++n) _Pragma("unroll") for (int k = 0; k < 2; ++k) dst[n][k] = *(const LAS bf16x8*)(lds + PG8_SB(b, h) + boff + n * 2048 + k * 1024); } while (0)
#define PG8_MMA(ai, bj, At, Bt) do { __builtin_amdgcn_s_setprio(1); _Pragma("unroll") for (int m = 0; m < 4; ++m) _Pragma("unroll") for (int n = 0; n < 2; ++n) _Pragma("unroll") for (int k = 0; k < 2; ++k) \
        acc[ai][bj][m][n] = mma_sel<I8>(Bt[n][k], At[m][k], acc[ai][bj][m][n]); __builtin_amdgcn_s_setprio(0); } while (0)
#define PG8_WAIT_V(n) asm volatile("s_waitcnt vmcnt(" #n ")" ::: "memory")
#define PG8_WAIT_L(n) asm volatile("s_waitcnt lgkmcnt(" #n ")" ::: "memory")
#define PG8_BAR __builtin_amdgcn_s_barrier()
#define PG8_SCHED __builtin_amdgcn_sched_barrier(0)

template <class Epi, class Sched, bool GATHER, bool HOOK = false, bool VARK = false, bool I8 = false>
__device__ __forceinline__ void gemm_phase(LAS uchar* lds, const int K, const int lda, const Sched& S, const Epi& E) {
    const int tid = ltid(), wid = __builtin_amdgcn_readfirstlane(tid >> 6), lane = tid & 63, wr = wid >> 2, wc = wid & 3, fr = lane & 15, fq = lane >> 4;
    int sR[2], sC[2];
    unsigned voffB[2], voA[2][2], nvoA[2][2];
#pragma unroll
    for (int i = 0; i < 2; ++i) { stage_rc(tid * 16 + i * 8192, sR[i], sC[i]); const int Rb = (sR[i] & ~31) + perm32(sR[i] & 31);
        voffB[i] = (unsigned)(Rb * K + sC[i]) * 2u;
#pragma unroll
        for (int h = 0; h < 2; ++h) { voA[h][i] = (unsigned)((h * HALF + sR[i]) * lda + sC[i]) * 2u; nvoA[h][i] = voA[h][i]; } }
    const size_t kstep = (size_t)(BK * 2);
    const size_t hstepB = (size_t)HALF * K * 2;
    const unsigned ldsw = (unsigned)wid * 1024u;
    const int aoff = lds_byte(wr * 64 + fr, fq * 8), boff = lds_byte(wc * 32 + fr, fq * 8);
    Unit cur, nxt; int ui = 0;
    if (!S.next(0, cur)) return;
    if constexpr (GATHER) {
#pragma unroll
        for (int i = 0; i < 2; ++i)
#pragma unroll
            for (int h = 0; h < 2; ++h) voA[h][i] = (unsigned)(cur.rows[h * HALF + sR[i]] * lda + sC[i]) * 2u;
    }
    f32x4 acc[2][2][4][2];
#pragma unroll
    for (int a = 0; a < 2; ++a)
#pragma unroll
        for (int b = 0; b < 2; ++b)
#pragma unroll
            for (int m = 0; m < 4; ++m)
#pragma unroll
                for (int n = 0; n < 2; ++n) acc[a][b][m][n] = (f32x4){0.f, 0.f, 0.f, 0.f};
    bf16x8 At[4][2], B0[2][2], B1[2][2];
    const char* cA = cur.A; const char* cB = cur.B;
    PG8_STAGE_B(PG8_SB(0, 0), cB); PG8_STAGE_B(PG8_SB(0, 1), cB + hstepB); PG8_STAGE_A(PG8_SA(0, 0), cA, voA, 0); PG8_STAGE_A(PG8_SA(0, 1), cA, voA, 1);
    if (wr == 1) PG8_BAR;
    PG8_WAIT_V(2); PG8_BAR;
    PG8_STAGE_B(PG8_SB(1, 0), cB + kstep); PG8_STAGE_A(PG8_SA(1, 0), cA + kstep, voA, 0); PG8_STAGE_B(PG8_SB(1, 1), cB + hstepB + kstep);
    PG8_WAIT_V(6); PG8_BAR;
    for (;;) {
        const int nt = VARK ? cur.kt : K / BK;
        const bool has_next = S.next(ui + 1, nxt);
        const char* nA = has_next ? nxt.A : cA; const char* nB = has_next ? nxt.B : cB;
        if constexpr (GATHER) {
            if (has_next) {
#pragma unroll
                for (int i = 0; i < 2; ++i)
#pragma unroll
                    for (int h = 0; h < 2; ++h) nvoA[h][i] = (unsigned)(nxt.rows[h * HALF + sR[i]] * lda + sC[i]) * 2u;
            } else {
#pragma unroll
                for (int i = 0; i < 2; ++i)
#pragma unroll
                    for (int h = 0; h < 2; ++h) nvoA[h][i] = voA[h][i];
            }
        }
#pragma unroll 1
        for (int t = 0; t < nt; t += 2) {
            if constexpr (HOOK) { if ((!VARK || cur.aux == 2) && t == (nt >> 1)) { int z = 0; asm volatile("" : "+v"(z)); E.scale(acc, cur, wr, wc, fr + z, fq); } }
            const bool last = (t == nt - 2);
            const char* a1 = cA + (size_t)(t + 1) * kstep;
            const char* a2 = last ? nA : cA + (size_t)(t + 2) * kstep; const char* b2 = last ? nB : cB + (size_t)(t + 2) * kstep;
            const char* a3 = a2 + kstep; const char* b3 = b2 + kstep;
            unsigned vo2[2][2];
#pragma unroll
            for (int i = 0; i < 2; ++i)
#pragma unroll
                for (int h = 0; h < 2; ++h) vo2[h][i] = (GATHER && last) ? nvoA[h][i] : voA[h][i];
            PG8_LDB(B0, 0, 0); PG8_LDB(B1, 0, 1); PG8_SCHED; PG8_LDA(At, 0, 0); PG8_STAGE_A(PG8_SA(1, 1), a1, voA, 1);
            PG8_WAIT_V(8); PG8_WAIT_L(0); PG8_BAR; PG8_MMA(0, 0, At, B0); PG8_MMA(0, 1, At, B1); PG8_BAR; PG8_SCHED;
            PG8_LDA(At, 0, 1); PG8_STAGE_B(PG8_SB(0, 0), b2); PG8_STAGE_B(PG8_SB(0, 1), b2 + hstepB); PG8_STAGE_A(PG8_SA(0, 0), a2, vo2, 0);
            PG8_WAIT_V(8); PG8_WAIT_L(0); PG8_BAR; PG8_MMA(1, 0, At, B0); PG8_MMA(1, 1, At, B1); PG8_BAR; PG8_SCHED;
            PG8_LDB(B0, 1, 0); PG8_LDB(B1, 1, 1); PG8_SCHED; PG8_LDA(At, 1, 0); PG8_STAGE_A(PG8_SA(0, 1), a2, vo2, 1);
            PG8_WAIT_V(8); PG8_WAIT_L(0); PG8_BAR; PG8_MMA(0, 0, At, B0); PG8_MMA(0, 1, At, B1); PG8_BAR; PG8_SCHED;
            PG8_LDA(At, 1, 1); PG8_STAGE_B(PG8_SB(1, 0), b3); PG8_STAGE_B(PG8_SB(1, 1), b3 + hstepB); PG8_STAGE_A(PG8_SA(1, 0), a3, vo2, 0);
            PG8_WAIT_V(8); PG8_WAIT_L(0); PG8_BAR; PG8_MMA(1, 0, At, B0); PG8_MMA(1, 1, At, B1); PG8_BAR; PG8_SCHED;
        }
        if (wr == 0) PG8_BAR;
        E(acc, cur, wr, wc, fr, fq);
        if (!has_next) break;
#pragma unroll
        for (int a = 0; a < 2; ++a)
#pragma unroll
            for (int b = 0; b < 2; ++b)
#pragma unroll
                for (int m = 0; m < 4; ++m)
#pragma unroll
                    for (int n = 0; n < 2; ++n) acc[a][b][m][n] = (f32x4){0.f, 0.f, 0.f, 0.f};
        cur = nxt; cA = nA; cB = nB; ++ui;
        if constexpr (GATHER) {
#pragma unroll
            for (int i = 0; i < 2; ++i)
#pragma unroll
                for (int h = 0; h < 2; ++h) voA[h][i] = nvoA[h][i];
        }
        if (wr == 1) PG8_BAR;
    }
    PG8_WAIT_V(0);
    PG8_BAR;
}
}
namespace epi {
using pg8::Unit;
#define EPI_ROWS(ai, m) (u.r0 + (ai) * 128 + wr * 64 + (m) * 16 + fr)
#define EPI_FENCE asm volatile("" ::: "memory")
#define EPI_FOR_AI_M _Pragma("unroll") for (int ai = 0; ai < 2; ++ai) _Pragma("unroll") for (int m = 0; m < 4; ++m)
__device__ __forceinline__ u32x4 pack8(const f32x4& a, const f32x4& b) { u32x4 w; w.x = cvt_pk_bf16(a[0], a[1]); w.y = cvt_pk_bf16(a[2], a[3]); w.z = cvt_pk_bf16(b[0], b[1]); w.w = cvt_pk_bf16(b[2], b[3]); return w; }
__device__ __forceinline__ void unpack8(const u32x4& w, f32x4& a, f32x4& b) { a = (f32x4){bflo(w.x), bfhi(w.x), bflo(w.y), bfhi(w.y)}; b = (f32x4){bflo(w.z), bfhi(w.z), bflo(w.w), bfhi(w.w)}; }

__device__ __forceinline__ u32x2 pack8u(const f32x4& a, const f32x4& b) { u32x2 w; w.x = 0u; w.y = 0u;
    w.x = __builtin_amdgcn_cvt_pk_u8_f32(a[0] * 255.0f, 0, w.x); w.x = __builtin_amdgcn_cvt_pk_u8_f32(a[1] * 255.0f, 1, w.x); w.x = __builtin_amdgcn_cvt_pk_u8_f32(a[2] * 255.0f, 2, w.x); w.x = __builtin_amdgcn_cvt_pk_u8_f32(a[3] * 255.0f, 3, w.x);
    w.y = __builtin_amdgcn_cvt_pk_u8_f32(b[0] * 255.0f, 0, w.y); w.y = __builtin_amdgcn_cvt_pk_u8_f32(b[1] * 255.0f, 1, w.y); w.y = __builtin_amdgcn_cvt_pk_u8_f32(b[2] * 255.0f, 2, w.y); w.y = __builtin_amdgcn_cvt_pk_u8_f32(b[3] * 255.0f, 3, w.y); return w; }
__device__ __forceinline__ void unpack8u(const u32x2& w, f32x4& a, f32x4& b) {
    a = (f32x4){(float)(w.x & 0xffu), (float)((w.x >> 8) & 0xffu), (float)((w.x >> 16) & 0xffu), (float)(w.x >> 24)};
    b = (f32x4){(float)(w.y & 0xffu), (float)((w.y >> 8) & 0xffu), (float)((w.y >> 16) & 0xffu), (float)(w.y >> 24)}; }
__device__ __forceinline__ void rot_pairs(f32x4& a, f32x4& b, const f32x4& cs0, const f32x4& cs1) {
    { const float x1 = a[0], x2 = a[1]; a[0] = x1 * cs0[0] - x2 * cs0[1]; a[1] = x2 * cs0[0] + x1 * cs0[1]; }
    { const float x1 = a[2], x2 = a[3]; a[2] = x1 * cs0[2] - x2 * cs0[3]; a[3] = x2 * cs0[2] + x1 * cs0[3]; }
    { const float x1 = b[0], x2 = b[1]; b[0] = x1 * cs1[0] - x2 * cs1[1]; b[1] = x2 * cs1[0] + x1 * cs1[1]; }
    { const float x1 = b[2], x2 = b[3]; b[2] = x1 * cs1[2] - x2 * cs1[3]; b[3] = x2 * cs1[2] + x1 * cs1[3]; }
}
struct InProj {
    bf16* U1; bf16* UC; bf16* KV; float* ssq; const f32x2* ropeA; const f32x2* ropeB; float qscale;
    __device__ __forceinline__ void operator()(f32x4 (&acc)[2][2][4][2], const Unit& u, int wr, int wc, int fr, int fq) const {
        const int pn = u.aux;
        if (pn >= 8) {
            EPI_FOR_AI_M { const int t = EPI_ROWS(ai, m);
#pragma unroll
                for (int bj = 0; bj < 2; ++bj) { const int ch = (pn - 8) * 256 + bj * 128 + wc * 32 + fq * 8; const int g = ch >> 4, q0 = ch & 15;
                    *(u32x4*)(UC + ((size_t)g * NCHUNK + (t >> 4)) * UC_LD + (t & 15) * 16 + q0) = pack8(acc[ai][bj][m][0], acc[ai][bj][m][1]); } }
            return;
        }
        const float sc = (pn < 2) ? qscale : 1.0f;
        EPI_FOR_AI_M { const int t = EPI_ROWS(ai, m);
            f32x4 v[2][2];
#pragma unroll
            for (int bj = 0; bj < 2; ++bj) { v[bj][0] = acc[ai][bj][m][0]; v[bj][1] = acc[ai][bj][m][1]; }
            if (pn < 4) {
                if (fq == 0) { const f32x4 cs0 = *(const f32x4*)(ropeB + (size_t)t * 4), cs1 = *(const f32x4*)(ropeB + (size_t)t * 4 + 2);
                    const float c[4] = {cs0[0], cs0[2], cs1[0], cs1[2]}, s[4] = {cs0[1], cs0[3], cs1[1], cs1[3]};
#pragma unroll
                    for (int bj = 0; bj < 2; ++bj)
#pragma unroll
                        for (int j = 0; j < 4; ++j) { const float x1 = v[bj][0][j], x2 = v[bj][1][j]; v[bj][0][j] = x1 * c[j] - x2 * s[j]; v[bj][1][j] = x2 * c[j] + x1 * s[j]; } }
#pragma unroll
                for (int bj = 0; bj < 2; ++bj) { v[bj][0] *= sc; v[bj][1] *= sc; }
            } else if (pn == 6) {
                float s = 0.f;
#pragma unroll
                for (int bj = 0; bj < 2; ++bj)
#pragma unroll
                    for (int n = 0; n < 2; ++n) { const f32x4 x = v[bj][n]; s += (x[0] * x[0] + x[1] * x[1]) + (x[2] * x[2] + x[3] * x[3]); }
                s += __shfl_xor(s, 16); s += __shfl_xor(s, 32);
                if (fq == 0) ssq[(size_t)t * 8 + wc] = s;
            } else if (pn == 7) {
                float s = 0.f;
#pragma unroll
                for (int n = 0; n < 2; ++n) { const f32x4 x = v[0][n]; s += (x[0] * x[0] + x[1] * x[1]) + (x[2] * x[2] + x[3] * x[3]); }
                s += __shfl_xor(s, 16); s += __shfl_xor(s, 32);
                if (fq == 0) ssq[(size_t)t * 8 + 4 + wc] = s;
                if (wc == 0) { const f32x4 cs0 = *(const f32x4*)(ropeA + (size_t)t * 16 + 4 * fq), cs1 = *(const f32x4*)(ropeA + (size_t)t * 16 + 4 * fq + 2); rot_pairs(v[1][0], v[1][1], cs0, cs1);
                    *(u32x4*)(KV + (size_t)t * KV_LD + 1024 + fq * 8) = pack8(v[1][0], v[1][1]); }
            }
            bf16* rowp = U1 + (size_t)t * U1_LD + pn * 256 + wc * 32 + fq * 8;
#pragma unroll
            for (int bj = 0; bj < 2; ++bj) if (!(pn == 7 && bj == 1)) *(u32x4*)(rowp + bj * 128) = pack8(v[bj][0], v[bj][1]);
            EPI_FENCE; }
    }
};
struct InProj8 { InProj base; const float* rs; const float* cs;
    __device__ __forceinline__ void operator()(f32x4 (&acc)[2][2][4][2], const Unit& u, int wr, int wc, int fr, int fq) const {
        float rv[8];
#pragma unroll
        for (int g = 0; g < 8; ++g) rv[g] = rs[EPI_ROWS(g >> 2, g & 3)];
        EPI_FOR_AI_M { const float r = rv[ai * 4 + m];
#pragma unroll
            for (int bj = 0; bj < 2; ++bj) { const float* cp = cs + u.c0 + bj * 128 + wc * 32 + fq * 8; asm volatile("" : "+v"(cp));
                const f32x4 c0 = *(const f32x4*)cp * r, c1 = *(const f32x4*)(cp + 4) * r;
#pragma unroll
                for (int j = 0; j < 4; ++j) { acc[ai][bj][m][0][j] = (float)__float_as_int(acc[ai][bj][m][0][j]) * c0[j]; acc[ai][bj][m][1][j] = (float)__float_as_int(acc[ai][bj][m][1][j]) * c1[j]; } }
            EPI_FENCE; }
        base(acc, u, wr, wc, fr, fq);
    }
};

struct QUp {
    bf16* Q; const float* ssq; const f32x2* ropeA; float qscale;
    __device__ __forceinline__ void operator()(f32x4 (&acc)[2][2][4][2], const Unit& u, int wr, int wc, int fr, int fq) const {
        EPI_FOR_AI_M { const int t = EPI_ROWS(ai, m); const f32x4 sp = *(const f32x4*)(ssq + (size_t)t * 8); const float rs = rsqrtf(((sp[0] + sp[1]) + (sp[2] + sp[3])) * (1.0f / 256.0f) + RMS_EPS) * qscale;
#pragma unroll
            for (int bj = 0; bj < 2; ++bj) { f32x4 a = acc[ai][bj][m][0] * rs, b = acc[ai][bj][m][1] * rs;
                const int gi = u.aux * 8 + bj * 4 + wc;
                if (gi % 3 == 2) { const f32x4 cs0 = *(const f32x4*)(ropeA + (size_t)t * 16 + 4 * fq), cs1 = *(const f32x4*)(ropeA + (size_t)t * 16 + 4 * fq + 2); rot_pairs(a, b, cs0, cs1); }
                *(u32x4*)(Q + (size_t)t * 768 + u.c0 + bj * 128 + wc * 32 + fq * 8) = pack8(a, b); }
            EPI_FENCE; }
    }
};
struct KVUp {
    bf16* KV; const float* ssq;
    __device__ __forceinline__ void operator()(f32x4 (&acc)[2][2][4][2], const Unit& u, int wr, int wc, int fr, int fq) const {
        EPI_FOR_AI_M { const int t = EPI_ROWS(ai, m); const f32x4 sp = *(const f32x4*)(ssq + (size_t)t * 8 + 4); const float rs = rsqrtf(((sp[0] + sp[1]) + (sp[2] + sp[3])) * (1.0f / 128.0f) + RMS_EPS);
#pragma unroll
            for (int bj = 0; bj < 2; ++bj) *(u32x4*)(KV + (size_t)t * KV_LD + u.c0 + bj * 128 + wc * 32 + fq * 8) = pack8(acc[ai][bj][m][0] * rs, acc[ai][bj][m][1] * rs);
            EPI_FENCE; }
    }
};
struct SsmS {
    bf16* S;
    __device__ __forceinline__ void operator()(f32x4 (&acc)[2][2][4][2], const Unit& u, int wr, int wc, int fr, int fq) const {
        EPI_FOR_AI_M { bf16* p = S + (size_t)EPI_ROWS(ai, m) * 128 + wc * 32 + fq * 8; *(u32x4*)p = pack8(acc[ai][0][m][0], acc[ai][0][m][1]); }
    }
};
struct SsmY {
    const bf16* UC; bf16* O3; const float* dvec;
    __device__ __forceinline__ void operator()(f32x4 (&acc)[2][2][4][2], const Unit& u, int wr, int wc, int fr, int fq) const {
        EPI_FOR_AI_M { const int rr = EPI_ROWS(ai, m); const int g = rr >> 12, ch = rr & 4095;
#pragma unroll
            for (int bj = 0; bj < 2; ++bj) { const int col = bj * 128 + wc * 32 + fq * 8, i = col >> 4, p0 = col & 15; const int t = ch * 16 + i;
                const u32x4 uw = *(const u32x4*)(UC + (size_t)rr * UC_LD + col); f32x4 ua, ub; unpack8(uw, ua, ub);
                const f32x4 da = *(const f32x4*)(dvec + g * 16 + p0), db = *(const f32x4*)(dvec + g * 16 + p0 + 4);
                f32x4 ya = acc[ai][bj][m][0] + da * ua, yb = acc[ai][bj][m][1] + db * ub;
#pragma unroll
                for (int j = 0; j < 4; ++j) { { const float y = ya[j]; ya[j] = y * fast_sigmoid(1.5957691216057308f * (y + 0.044715f * y * y * y)); }
                                              { const float y = yb[j]; yb[j] = y * fast_sigmoid(1.5957691216057308f * (y + 0.044715f * y * y * y)); } }
                *(u32x4*)(O3 + (size_t)t * O3_LD + 1024 + g * 16 + p0) = pack8(ya, yb); }
            EPI_FENCE; }
    }
};
struct Gate {
    uchar* G; const float* bias;
    __device__ __forceinline__ void operator()(f32x4 (&acc)[2][2][4][2], const Unit& u, int wr, int wc, int fr, int fq) const {
        EPI_FOR_AI_M { uchar* rowp = G + (size_t)EPI_ROWS(ai, m) * G_LD + u.c0 + wc * 32 + fq * 8;
#pragma unroll
            for (int bj = 0; bj < 2; ++bj) { const float* bp = bias + u.c0 + bj * 128 + wc * 32 + fq * 8;
                f32x4 a = acc[ai][bj][m][0] + *(const f32x4*)bp, b = acc[ai][bj][m][1] + *(const f32x4*)(bp + 4);
#pragma unroll
                for (int j = 0; j < 4; ++j) { a[j] = fast_sigmoid(a[j]); b[j] = fast_sigmoid(b[j]); }
                *(u32x2*)(rowp + bj * 128) = pack8u(a, b); }
            EPI_FENCE; }
    }
};
struct Gate8 {
    uchar* G; const float* bias; const float* rs; const float* cs;
    __device__ __forceinline__ void operator()(f32x4 (&acc)[2][2][4][2], const Unit& u, int wr, int wc, int fr, int fq) const {
        float rv[8];
#pragma unroll
        for (int g = 0; g < 8; ++g) rv[g] = rs[EPI_ROWS(g >> 2, g & 3)];
        EPI_FOR_AI_M { const int t = EPI_ROWS(ai, m); const float r = rv[ai * 4 + m]; uchar* rowp = G + (size_t)t * G_LD + u.c0 + wc * 32 + fq * 8;
#pragma unroll
            for (int bj = 0; bj < 2; ++bj) { const int col = u.c0 + bj * 128 + wc * 32 + fq * 8; const float* bp = bias + col; const float* cp = cs + col;
                const f32x4 c0 = *(const f32x4*)cp * r, c1 = *(const f32x4*)(cp + 4) * r; f32x4 a = *(const f32x4*)bp, b = *(const f32x4*)(bp + 4);
#pragma unroll
                for (int j = 0; j < 4; ++j) { a[j] = fast_sigmoid((float)__float_as_int(acc[ai][bj][m][0][j]) * c0[j] + a[j]); b[j] = fast_sigmoid((float)__float_as_int(acc[ai][bj][m][1][j]) * c1[j] + b[j]); }
                *(u32x2*)(rowp + bj * 128) = pack8u(a, b); }
            EPI_FENCE; }
    }
};
struct Glu {
    bf16* MG; const uchar* G;
    __device__ __forceinline__ void operator()(f32x4 (&acc)[2][2][4][2], const Unit& u, int wr, int wc, int fr, int fq) const {
        constexpr int D = 4; u32x2 L[8];
        const int col = u.c0 + wc * 32 + fq * 8;
        const uchar* gp = G + (size_t)(u.r0 + wr * 64 + fr) * G_LD + 2048 + col;
#pragma unroll
        for (int g = 0; g < D; ++g) L[g] = *(const u32x2*)(gp + (size_t)((g >> 2) * 128 + (g & 3) * 16) * G_LD);
#pragma unroll
        for (int g = 0; g < 8; ++g) { const int ai = g >> 2, m = g & 3;
            if (g + D < 8) L[g + D] = *(const u32x2*)(gp + (size_t)(((g + D) >> 2) * 128 + ((g + D) & 3) * 16) * G_LD);
            EPI_FENCE;
            const int t = EPI_ROWS(ai, m); f32x4 ga, gb; unpack8u(L[g], ga, gb);
            f32x4 a = acc[ai][0][m][0], b = acc[ai][0][m][1]; const f32x4 sa = acc[ai][1][m][0], sb = acc[ai][1][m][1];
#pragma unroll
            for (int j = 0; j < 4; ++j) { a[j] = (ga[j] * (1.0f / 255.0f)) * a[j] * fast_sigmoid(sa[j]); b[j] = (gb[j] * (1.0f / 255.0f)) * b[j] * fast_sigmoid(sb[j]); }
            *(u32x4*)(MG + (size_t)t * 1024 + col) = pack8(a, b); }
    }
};
struct Branch {
    bf16* MG; const uchar* G; int goff;
    __device__ __forceinline__ void operator()(f32x4 (&acc)[2][2][4][2], const Unit& u, int wr, int wc, int fr, int fq) const {
        constexpr int D = 3; u32x2 LG[8][2]; u32x4 LM[8][2];
        const int col = u.c0 + wc * 32 + fq * 8; const size_t row = (size_t)(u.r0 + wr * 64 + fr);
        const uchar* gp = G + row * G_LD + goff + u.aux * 1024 + col; bf16* mp = MG + row * 1024 + col;
#define BR_LOAD(g) do { const size_t ro = (size_t)(((g) >> 2) * 128 + ((g) & 3) * 16); _Pragma("unroll") for (int bj = 0; bj < 2; ++bj) { LG[g][bj] = *(const u32x2*)(gp + ro * G_LD + bj * 128); LM[g][bj] = *(const u32x4*)(mp + ro * 1024 + bj * 128); } } while (0)
#pragma unroll
        for (int g = 0; g < D; ++g) BR_LOAD(g);
#pragma unroll
        for (int g = 0; g < 8; ++g) { const int ai = g >> 2, m = g & 3;
            if (g + D < 8) BR_LOAD(g + D);
            EPI_FENCE;
            const size_t ro = (size_t)(ai * 128 + m * 16);
#pragma unroll
            for (int bj = 0; bj < 2; ++bj) { f32x4 ga, gb, ma, mb; unpack8u(LG[g][bj], ga, gb); unpack8(LM[g][bj], ma, mb);
                *(u32x4*)(mp + ro * 1024 + bj * 128) = pack8(ma + (ga * (1.0f / 255.0f)) * acc[ai][bj][m][0], mb + (gb * (1.0f / 255.0f)) * acc[ai][bj][m][1]); } }
#undef BR_LOAD
    }
};
struct BranchAB {
    bf16* MG; const uchar* G;
    __device__ __forceinline__ void scale(f32x4 (&acc)[2][2][4][2], const Unit& u, int wr, int wc, int fr, int fq) const {
        constexpr int D = 3; u32x2 LA[8][2], LB[8][2];
        const int col = u.c0 + wc * 32 + fq * 8; const size_t row = (size_t)(u.r0 + wr * 64 + fr);
        const uchar* gp = G + row * G_LD + col;
#define BS_LOAD(g) do { const size_t ro = (size_t)(((g) >> 2) * 128 + ((g) & 3) * 16); _Pragma("unroll") for (int bj = 0; bj < 2; ++bj) { LA[g][bj] = *(const u32x2*)(gp + ro * G_LD + bj * 128); LB[g][bj] = *(const u32x2*)(gp + ro * G_LD + 1024 + bj * 128); } } while (0)
#pragma unroll
        for (int g = 0; g < D; ++g) BS_LOAD(g);
#pragma unroll
        for (int g = 0; g < 8; ++g) { const int ai = g >> 2, m = g & 3;
            if (g + D < 8) BS_LOAD(g + D);
            EPI_FENCE;
#pragma unroll
            for (int bj = 0; bj < 2; ++bj) { f32x4 a0, a1, b0, b1; unpack8u(LA[g][bj], a0, a1); unpack8u(LB[g][bj], b0, b1);
#pragma unroll
                for (int j = 0; j < 4; ++j) { acc[ai][bj][m][0][j] *= a0[j] * __builtin_amdgcn_rcpf(fmaxf(b0[j], 1.0f)); acc[ai][bj][m][1][j] *= a1[j] * __builtin_amdgcn_rcpf(fmaxf(b1[j], 1.0f)); } } }
#undef BS_LOAD
    }
    __device__ __forceinline__ void operator()(f32x4 (&acc)[2][2][4][2], const Unit& u, int wr, int wc, int fr, int fq) const {
        constexpr int D = 3; u32x2 LG[8][2]; u32x4 LM[8][2];
        const int col = u.c0 + wc * 32 + fq * 8; const size_t row = (size_t)(u.r0 + wr * 64 + fr);
        const uchar* gp = G + row * G_LD + 1024 + col; bf16* mp = MG + row * 1024 + col;
#define BR_LOAD(g) do { const size_t ro = (size_t)(((g) >> 2) * 128 + ((g) & 3) * 16); _Pragma("unroll") for (int bj = 0; bj < 2; ++bj) { LG[g][bj] = *(const u32x2*)(gp + ro * G_LD + bj * 128); LM[g][bj] = *(const u32x4*)(mp + ro * 1024 + bj * 128); } } while (0)
#pragma unroll
        for (int g = 0; g < D; ++g) BR_LOAD(g);
#pragma unroll
        for (int g = 0; g < 8; ++g) { const int ai = g >> 2, m = g & 3;
            if (g + D < 8) BR_LOAD(g + D);
            EPI_FENCE;
            const size_t ro = (size_t)(ai * 128 + m * 16);
#pragma unroll
            for (int bj = 0; bj < 2; ++bj) { f32x4 ga, gb, ma, mb; unpack8u(LG[g][bj], ga, gb); unpack8(LM[g][bj], ma, mb);
#pragma unroll
                for (int j = 0; j < 4; ++j) { ga[j] = fmaxf(ga[j], 1.0f) * (1.0f / 255.0f); gb[j] = fmaxf(gb[j], 1.0f) * (1.0f / 255.0f); }
                *(u32x4*)(mp + ro * 1024 + bj * 128) = pack8(ma + ga * acc[ai][bj][m][0], mb + gb * acc[ai][bj][m][1]); } }
#undef BR_LOAD
    }
};
struct GluAB { Glu g; BranchAB b;
    __device__ __forceinline__ void scale(f32x4 (&acc)[2][2][4][2], const Unit& u, int wr, int wc, int fr, int fq) const { b.scale(acc, u, wr, wc, fr, fq); }
    __device__ __forceinline__ void operator()(f32x4 (&acc)[2][2][4][2], const Unit& u, int wr, int wc, int fr, int fq) const {
        if (u.aux < 2) g(acc, u, wr, wc, fr, fq); else b(acc, u, wr, wc, fr, fq); }
};
struct OutProj {
    bf16* Z; const bf16* XB;
    __device__ __forceinline__ void operator()(f32x4 (&acc)[2][2][4][2], const Unit& u, int wr, int wc, int fr, int fq) const {
        constexpr int D = 3; u32x4 L[8][2];
        const int col = u.c0 + wc * 32 + fq * 8; const size_t row = (size_t)(u.r0 + wr * 64 + fr);
        const bf16* xp = XB + row * 1024 + col; bf16* zp = Z + row * 1024 + col;
#define OP_LOAD(g) do { const size_t ro = (size_t)(((g) >> 2) * 128 + ((g) & 3) * 16); L[g][0] = *(const u32x4*)(xp + ro * 1024); L[g][1] = *(const u32x4*)(xp + ro * 1024 + 128); } while (0)
#pragma unroll
        for (int g = 0; g < D; ++g) OP_LOAD(g);
#pragma unroll
        for (int g = 0; g < 8; ++g) { const int ai = g >> 2, m = g & 3;
            if (g + D < 8) OP_LOAD(g + D);
            EPI_FENCE;
            const size_t ro = (size_t)(ai * 128 + m * 16);
#pragma unroll
            for (int bj = 0; bj < 2; ++bj) { f32x4 xa, xb; unpack8(L[g][bj], xa, xb);
                *(u32x4*)(zp + ro * 1024 + bj * 128) = pack8(xa * DN_ALPHA + acc[ai][bj][m][0], xb * DN_ALPHA + acc[ai][bj][m][1]); } }
#undef OP_LOAD
    }
};
struct Moe1 {
    bf16* H;
    __device__ __forceinline__ void operator()(f32x4 (&acc)[2][2][4][2], const Unit& u, int wr, int wc, int fr, int fq) const {
        EPI_FOR_AI_M { const int r = EPI_ROWS(ai, m);
            f32x4 a = acc[ai][0][m][0], b = acc[ai][0][m][1]; const f32x4 ua = acc[ai][1][m][0], ub = acc[ai][1][m][1];
#pragma unroll
            for (int j = 0; j < 4; ++j) { a[j] = a[j] * fast_sigmoid(a[j]) * ua[j]; b[j] = b[j] * fast_sigmoid(b[j]) * ub[j]; }
            *(u32x4*)(H + (size_t)r * 512 + u.c0 + wc * 32 + fq * 8) = pack8(a, b); }
    }
};
struct Moe1_8 {
    bf16* H; const float* rs; const float* cm;
    __device__ __forceinline__ void operator()(f32x4 (&acc)[2][2][4][2], const Unit& u, int wr, int wc, int fr, int fq) const {
        const float* cp = cm + (size_t)u.aux * 1024 + 2 * u.c0 + wc * 32 + fq * 8;
        int vr[8]; float sc[8];
#pragma unroll
        for (int g = 0; g < 8; ++g) vr[g] = u.rows[(g >> 2) * 128 + wr * 64 + (g & 3) * 16 + fr];
#pragma unroll
        for (int g = 0; g < 8; ++g) { const int t = vr[g] - (vr[g] >= XQ_SPLIT * 256 + XQ_VOFF ? XQ_VOFF : 0); sc[g] = rs[t] * (1.0f / 127.0f); }
        EPI_FOR_AI_M { const int r = EPI_ROWS(ai, m); const float s = sc[ai * 4 + m]; const float* cq = cp; asm volatile("" : "+v"(cq));
            const f32x4 cg0 = *(const f32x4*)cq, cg1 = *(const f32x4*)(cq + 4), cu0 = *(const f32x4*)(cq + 128), cu1 = *(const f32x4*)(cq + 132);
            f32x4 a, b;
#pragma unroll
            for (int j = 0; j < 4; ++j) { const float ga = (float)__float_as_int(acc[ai][0][m][0][j]) * (cg0[j] * s), gb = (float)__float_as_int(acc[ai][0][m][1][j]) * (cg1[j] * s);
                a[j] = ga * fast_sigmoid(ga) * ((float)__float_as_int(acc[ai][1][m][0][j]) * (cu0[j] * s)); b[j] = gb * fast_sigmoid(gb) * ((float)__float_as_int(acc[ai][1][m][1][j]) * (cu1[j] * s)); }
            *(u32x4*)(H + (size_t)r * 512 + u.c0 + wc * 32 + fq * 8) = pack8(a, b); EPI_FENCE; }
    }
};
__device__ __forceinline__ unsigned pack4_fp8(const f32x4& a) {
    const float c0 = __builtin_amdgcn_fmed3f(a[0], -448.f, 448.f), c1 = __builtin_amdgcn_fmed3f(a[1], -448.f, 448.f), c2 = __builtin_amdgcn_fmed3f(a[2], -448.f, 448.f), c3 = __builtin_amdgcn_fmed3f(a[3], -448.f, 448.f);
    int w = __builtin_amdgcn_cvt_pk_fp8_f32(c0, c1, 0, false); w = __builtin_amdgcn_cvt_pk_fp8_f32(c2, c3, w, true); return (unsigned)w; }
struct Moe2 {
    uchar* YB;
    __device__ __forceinline__ void operator()(f32x4 (&acc)[2][2][4][2], const Unit& u, int wr, int wc, int fr, int fq) const {
        EPI_FOR_AI_M { uchar* rowp = YB + (size_t)EPI_ROWS(ai, m) * 1024 + u.c0 + wc * 32 + fq * 8;
#pragma unroll
            for (int bj = 0; bj < 2; ++bj) { u32x2 w; w.x = pack4_fp8(acc[ai][bj][m][0]); w.y = pack4_fp8(acc[ai][bj][m][1]); *(u32x2*)(rowp + bj * 128) = w; } }
    }
};
#undef EPI_ROWS
#undef EPI_FOR_AI_M
#undef EPI_FENCE
}
namespace attn {
constexpr int KVBLK = 64, QB = 256, NBUF = 4;
template <int MODE> struct Cfg {
    static constexpr int KPC = MODE == 0 ? 13 : 9;
    static constexpr int KROW = KPC * 16, KBYTES = 64 * KROW, NKI = KPC, VBYTES = 8192, BUF = KBYTES + VBYTES;
    static constexpr int DUMMY = NBUF * BUF;
    static constexpr int NS = MODE == 0 ? 6 : 2;
    static constexpr int NMAP = MODE == 0 ? 1 : 2;
};
__device__ __forceinline__ int crow(int r, int hi) { return (r & 3) + 8 * (r >> 2) + 4 * hi; }
__device__ __forceinline__ s16x4 vtr(const LAS uchar* p) { return __builtin_bit_cast(s16x4, __builtin_amdgcn_ds_read_tr16_b64_v4i16((LAS s16x4*)p)); }
__device__ __forceinline__ void glds_s(const char* sbase, unsigned voff, unsigned lds_dst) {
    unsigned keep; const unsigned d = __builtin_amdgcn_readfirstlane(lds_dst);
    asm volatile("s_mov_b32 %0, m0\n\ts_mov_b32 m0, %3\n\ts_nop 0\n\tglobal_load_lds_dwordx4 %1, %2\n\ts_mov_b32 m0, %0" : "=&s"(keep) : "v"(voff), "s"(sbase), "s"(d) : "memory");
}
__device__ __forceinline__ float max3f(float a, float b, float c) { return fmaxf(fmaxf(a, b), c); }
__device__ __forceinline__ bool unit_of(int i, int G, int c, int& bh, int& qb) {
    const int idx = (i & 1) ? (i * G + (G - 1 - c)) : (i * G + c);
    if (idx >= 2048) return false;
    qb = 15 - (idx >> 7); bh = idx & 127; return true;
}
__device__ __forceinline__ void store_o(bf16* dst, const f32x16 (&o)[2], int hi) {
#pragma unroll
    for (int d0 = 0; d0 < 2; ++d0)
#pragma unroll
        for (int k = 0; k < 4; ++k) { u32x2 w; w.x = cvt_pk_bf16(o[d0][4 * k], o[d0][4 * k + 1]); w.y = cvt_pk_bf16(o[d0][4 * k + 2], o[d0][4 * k + 3]); *(u32x2*)(dst + d0 * 32 + 8 * k + 4 * hi) = w; }
}
#define ATT_THR 8.0f
__device__ __forceinline__ void softmax_step(f32x16& p0, f32x16& p1, float& mrun, float& lrun, f32x16 (&o)[2], bool first, bf16x8 (&pb)[2][2]) {
    float a = max3f(p0[0], p0[1], p0[2]), b = max3f(p1[0], p1[1], p1[2]);
#pragma unroll
    for (int r = 3; r < 15; r += 2) { a = max3f(a, p0[r], p0[r + 1]); b = max3f(b, p1[r], p1[r + 1]); }
    float mx = max3f(a, b, fmaxf(p0[15], p1[15]));
    mx = fmaxf(mx, __shfl_xor(mx, 32));
    if (first || __any(mx > ATT_THR)) {
        const float dl = first ? mx : fmaxf(mx, 0.f); mrun += dl;
        const float alpha = __builtin_amdgcn_exp2f(-dl); lrun *= alpha;
#pragma unroll
        for (int r = 0; r < 16; ++r) { p0[r] -= dl; p1[r] -= dl; o[0][r] *= alpha; o[1][r] *= alpha; }
    }
    float ps = 0.f;
#pragma unroll
    for (int r = 0; r < 16; ++r) { p0[r] = __builtin_amdgcn_exp2f(p0[r]); p1[r] = __builtin_amdgcn_exp2f(p1[r]); ps += p0[r] + p1[r]; }
    lrun += ps;
#pragma unroll
    for (int s = 0; s < 2; ++s) {
        u32x4 w0, w1;
        w0.x = cvt_pk_bf16(p0[8 * s + 0], p0[8 * s + 1]); w0.y = cvt_pk_bf16(p0[8 * s + 2], p0[8 * s + 3]); w0.z = cvt_pk_bf16(p0[8 * s + 4], p0[8 * s + 5]); w0.w = cvt_pk_bf16(p0[8 * s + 6], p0[8 * s + 7]);
        w1.x = cvt_pk_bf16(p1[8 * s + 0], p1[8 * s + 1]); w1.y = cvt_pk_bf16(p1[8 * s + 2], p1[8 * s + 3]); w1.z = cvt_pk_bf16(p1[8 * s + 4], p1[8 * s + 5]); w1.w = cvt_pk_bf16(p1[8 * s + 6], p1[8 * s + 7]);
        pb[0][s] = __builtin_bit_cast(bf16x8, w0); pb[1][s] = __builtin_bit_cast(bf16x8, w1);
    }
}

struct UnitP { const char* kb; const char* vb; int hoff; int NT; int b, h, q0; };
template <int MODE>
__device__ __forceinline__ bool unit_params(int i, int G, int c, const uchar* ws, UnitP& u) {
    int bh, qb; if (!unit_of(i, G, c, bh, qb)) return false;
    u.b = bh >> 3; u.h = bh & 7; u.q0 = qb * 256; u.NT = (u.q0 + QB) / KVBLK; const size_t tb = (size_t)u.b * SEQ;
    if (MODE == 0) { u.kb = (const char*)(ws + WS_KV) + tb * KV_LD * 2; u.vb = u.kb + (u.h * 128 + 64) * 2; u.hoff = u.h * 256; }
    else { u.kb = (const char*)(ws + WS_U1) + tb * U1_LD * 2 + (512 + u.h * 64) * 2; u.vb = (const char*)(ws + WS_U1) + tb * U1_LD * 2 + (1024 + u.h * 64) * 2; u.hoff = 0; }
    return true;
}

template <int MODE>
__device__ __forceinline__ void attn_stream(PT pt, int l, LAS uchar* lds, int c, int G, int vcu) {
    typedef Cfg<MODE> C;
    constexpr int LD = MODE == 0 ? KV_LD : U1_LD;
    constexpr unsigned TSTRIDE = KVBLK * LD * 2;
    const int tid = ltid(), lane = tid & 63, r32 = lane & 31, hi = lane >> 5; const int wid = __builtin_amdgcn_readfirstlane(tid >> 6);
    const uchar* ws = (const uchar*)ldptr(pt, I_WS);
    unsigned voK[2]; bool nope[2];
#pragma unroll
    for (int j = 0; j < 2; ++j) { const int i = wid + 8 * j; const int s = (i < C::NKI ? i : wid) * 64 + lane, row = s / C::KPC, pc = s % C::KPC;
        if (MODE == 0) { nope[j] = pc < 8 || pc == 12; voK[j] = (unsigned)(row * LD + (pc < 8 ? pc * 8 : (pc == 12 ? 0 : 1024 + (pc - 8) * 8))) * 2u; }
        else { nope[j] = false; voK[j] = (unsigned)(row * LD + (pc < 8 ? pc * 8 : 0)) * 2u; } }
    const int vs = wid * 64 + lane;
    const unsigned voV = (unsigned)(((vs & 255) >> 2) * LD + (vs >> 8) * 32 + (vs & 3) * 8) * 2u;
    const unsigned lds0 = (unsigned)(size_t)lds;
    const unsigned dK0 = (unsigned)wid * 1024u, dV = (unsigned)(C::KBYTES + wid * 1024);
    const bool k1real = (wid + 8 < C::NKI); const unsigned dK1 = k1real ? (unsigned)(wid + 8) * 1024u : 0u, dDummy = lds0 + (unsigned)(C::DUMMY + wid * 1024);
    const int kro = r32 * C::KROW + hi * 16;
    const int vro = C::KBYTES + (4 * hi + ((lane & 15) >> 2)) * 64 + (((lane >> 4) & 1) * 16 + (lane & 3) * 4) * 2;
    float lam_val = 0.f, lam_init = 0.f;
    if (MODE == 1) { const float* lam = (const float*)ldptr(pt, I_LAMBDA) + l * 128; lam_init = 0.8f - 0.6f * expf(-0.3f * (float)l); float s1 = 0.f, s2 = 0.f;
        for (int j = 0; j < 32; ++j) { s1 += lam[j] * lam[32 + j]; s2 += lam[64 + j] * lam[96 + j]; }
        lam_val = expf(s1) - expf(s2) + lam_init; }
    const int NGW = G * 8, gw = vcu * 8 + wid; int pj = 0, tilectr = 0;
    constexpr int NGRAN = 32 * (32 * 16 + 16 * 16);
    const float* mo_g = (const float*)ldptr(pt, I_MG) + (size_t)l * 32 * 1024 * 512; const float* mo_u = (const float*)ldptr(pt, I_MU) + (size_t)l * 32 * 1024 * 512; const float* mo_d = (const float*)ldptr(pt, I_MD) + (size_t)l * 32 * 512 * 1024;
    f32x4 bgv[8]; bf16* bgdst = nullptr; uchar* bgdst8 = nullptr; float* bgcm = nullptr; f32x4 bgsc = {0.f, 0.f, 0.f, 0.f}; int bgkind = 0;
    float* mcm = (float*)(const_cast<uchar*>(ws) + WS_MCM); uchar* wm1_8 = const_cast<uchar*>(ws) + WS_WM1;
    const int NBG = NGRAN + ((l + 1 < DEPTH) ? 32 * 512 : 0);
#define BG_MORE() (MODE == 0 && gw + NGW * pj < NBG)
#define BG_LOAD() do { const int g_ = gw + NGW * pj; ++pj; const int cc_ = lane & 15, kr_ = lane >> 4; const float* src_; int ldw_, k0_, n0_; \
        if (g_ < 32 * 512 || g_ >= NGRAN) { const bool mx_ = g_ >= NGRAN; const int gg_ = mx_ ? g_ - NGRAN : g_; const int e_ = gg_ >> 9, r_ = gg_ & 511, nb_ = r_ & 15; k0_ = (r_ >> 4) * 32; n0_ = nb_ * 64; const int nt_ = n0_ >> 8, i_ = n0_ & 255; \
            const size_t lo_ = mx_ ? (size_t)32 * 1024 * 512 : 0; \
            src_ = (i_ < 128 ? mo_g + lo_ + 128 * nt_ + i_ : mo_u + lo_ + 128 * nt_ + (i_ - 128)) + (size_t)e_ * 1024 * 512; ldw_ = 512; \
            bgcm = mcm + (size_t)((mx_ ? l + 1 : l) * 32 + e_) * 1024 + n0_ + 4 * cc_; \
            if (mx_) bgkind = 2; else { bgkind = 0; bgsc = *(const f32x4*)bgcm; bgdst8 = wm1_8 + (size_t)e_ * 1024 * 1024 + (size_t)(n0_ + 4 * cc_) * 1024 + k0_ + 8 * kr_; } } \
        else { const int g2_ = g_ - 32 * 512, e_ = g2_ >> 8, r_ = g2_ & 255, nb_ = r_ & 15; k0_ = (r_ >> 4) * 32; n0_ = nb_ * 64; bgkind = 1; \
            src_ = mo_d + (size_t)e_ * 512 * 1024 + n0_; ldw_ = 1024; bgdst = (bf16*)(ws + WS_WM2) + (size_t)e_ * 1024 * 512 + (size_t)(n0_ + 4 * cc_) * 512 + k0_ + 8 * kr_; } \
        _Pragma("unroll") for (int j_ = 0; j_ < 8; ++j_) bgv[j_] = *(const f32x4*)(src_ + (size_t)(k0_ + 8 * kr_ + j_) * ldw_ + 4 * cc_); } while (0)
#define BG_STORE() do { \
        if (bgkind == 1) { _Pragma("unroll") for (int i_ = 0; i_ < 4; ++i_) { u32x4 o_; o_.x = pk2(bgv[0][i_], bgv[1][i_]); o_.y = pk2(bgv[2][i_], bgv[3][i_]); o_.z = pk2(bgv[4][i_], bgv[5][i_]); o_.w = pk2(bgv[6][i_], bgv[7][i_]); *(u32x4*)(bgdst + (size_t)i_ * 512) = o_; } } \
        else if (bgkind == 0) { _Pragma("unroll") for (int i_ = 0; i_ < 4; ++i_) { const float inv_ = 127.0f / fmaxf(bgsc[i_], 1e-30f); u32x2 o_; \
            o_.x = pack4_i8(bgv[0][i_] * inv_, bgv[1][i_] * inv_, bgv[2][i_] * inv_, bgv[3][i_] * inv_); o_.y = pack4_i8(bgv[4][i_] * inv_, bgv[5][i_] * inv_, bgv[6][i_] * inv_, bgv[7][i_] * inv_); *(u32x2*)(bgdst8 + (size_t)i_ * 1024) = o_; } } \
        else { f32x4 m_; _Pragma("unroll") for (int i_ = 0; i_ < 4; ++i_) { float x_ = fabsf(bgv[0][i_]); _Pragma("unroll") for (int j_ = 1; j_ < 8; ++j_) x_ = fmaxf(x_, fabsf(bgv[j_][i_])); x_ = fmaxf(x_, __shfl_xor(x_, 16)); x_ = fmaxf(x_, __shfl_xor(x_, 32)); m_[i_] = x_; } \
            if (lane < 16) { _Pragma("unroll") for (int i_ = 0; i_ < 4; ++i_) atomicMax((int*)(bgcm + i_), __float_as_int(m_[i_])); } } } while (0)
    UnitP cu, nu; int ci = 0, pi = 0;
    if (!unit_params<MODE>(0, G, c, ws, cu)) return;
    const char* pk = cu.kb; const char* pv = cu.vb; int prem = cu.NT; bool pvalid = true;
    unsigned pvo0 = voK[0] + (nope[0] ? (unsigned)cu.hoff : 0u), pvo1 = voK[1] + (nope[1] ? (unsigned)cu.hoff : 0u);
    unsigned nbuf = 0;
#define ATT_ISSUE() do { const unsigned _b = lds0 + nbuf * (unsigned)C::BUF; const unsigned _d0 = __builtin_amdgcn_readfirstlane(_b + dK0), _d1 = __builtin_amdgcn_readfirstlane(k1real ? _b + dK1 : dDummy), _d2 = __builtin_amdgcn_readfirstlane(_b + dV); unsigned _keep; \
        asm volatile("s_mov_b32 %0, m0\n\ts_mov_b32 m0, %4\n\ts_nop 0\n\tglobal_load_lds_dwordx4 %1, %7\n\ts_mov_b32 m0, %5\n\ts_nop 0\n\tglobal_load_lds_dwordx4 %2, %7\n\ts_mov_b32 m0, %6\n\ts_nop 0\n\tglobal_load_lds_dwordx4 %3, %8\n\ts_mov_b32 m0, %0" \
            : "=&s"(_keep) : "v"(pvo0), "v"(pvo1), "v"(voV), "s"(_d0), "s"(_d1), "s"(_d2), "s"(pk), "s"(pv) : "memory"); \
        nbuf = (nbuf + 1) & (NBUF - 1); \
        if (pvalid) { if (--prem == 0) { if (unit_params<MODE>(pi + 1, G, c, ws, nu)) { ++pi; pk = nu.kb; pv = nu.vb; prem = nu.NT; pvo0 = voK[0] + (nope[0] ? (unsigned)nu.hoff : 0u); pvo1 = voK[1] + (nope[1] ? (unsigned)nu.hoff : 0u); } else { pvalid = false; } } \
                      else { pk += TSTRIDE; pv += TSTRIDE; } } } while (0)
    ATT_ISSUE(); ATT_ISSUE(); ATT_ISSUE();
    asm volatile("s_waitcnt vmcnt(6)" ::: "memory"); __builtin_amdgcn_s_barrier(); asm volatile("" ::: "memory");
    unsigned cbuf = 0;
    for (;;) {
        const size_t tq = (size_t)cu.b * SEQ + cu.q0 + wid * 32 + r32;
        bf16x8 qf[C::NMAP][C::NS];
        if (MODE == 0) { const bf16* qp = (const bf16*)(ws + WS_Q) + tq * 768 + cu.h * 96;
#pragma unroll
            for (int s = 0; s < C::NS; ++s) qf[0][s] = *(const bf16x8*)(qp + s * 16 + hi * 8); }
        else { const bf16* qp = (const bf16*)(ws + WS_U1) + tq * U1_LD + cu.h * 64;
#pragma unroll
            for (int mp = 0; mp < C::NMAP; ++mp)
#pragma unroll
                for (int s = 0; s < C::NS; ++s) qf[mp][s] = *(const bf16x8*)(qp + mp * 32 + s * 16 + hi * 8); }
#pragma unroll
        for (int mp = 0; mp < C::NMAP; ++mp)
#pragma unroll
            for (int s = 0; s < C::NS; ++s) asm volatile("" : "+v"(qf[mp][s]));
        float mrun[C::NMAP], lrun[C::NMAP]; f32x16 o[C::NMAP][2], negm[C::NMAP];
#pragma unroll
        for (int mp = 0; mp < C::NMAP; ++mp) { mrun[mp] = 0.f; lrun[mp] = 0.f; o[mp][0] = f32x16{}; o[mp][1] = f32x16{}; negm[mp] = f32x16{}; }
        const int qabs = cu.q0 + wid * 32 + r32;
        const int last_tile = (cu.q0 + wid * 32 + 31) / KVBLK;
        const int first_band = (cu.q0 + wid * 32) / KVBLK;
#define ATT_TILE(MASKED) do { \
                bf16x8 pb[C::NMAP][2][2]; \
_Pragma("unroll") \
                for (int mp = 0; mp < C::NMAP; ++mp) { \
                    f32x16 p0, p1; \
                    { bf16x8 ka[C::NS], kb[C::NS];            \
_Pragma("unroll") \
                    for (int s = 0; s < C::NS; ++s) { ka[s] = *(const LAS bf16x8*)(buf + kro + mp * 64 + s * 32); kb[s] = *(const LAS bf16x8*)(buf + kro + 32 * C::KROW + mp * 64 + s * 32); } \
                    __builtin_amdgcn_sched_barrier(0); \
_Pragma("unroll") \
                    for (int s = 0; s < C::NS; ++s) { \
                        p0 = __builtin_amdgcn_mfma_f32_32x32x16_bf16(ka[s], qf[mp][s], s == 0 ? negm[mp] : p0, 0, 0, 0); \
                        p1 = __builtin_amdgcn_mfma_f32_32x32x16_bf16(kb[s], qf[mp][s], s == 0 ? negm[mp] : p1, 0, 0, 0); \
                    } } \
                    if (MASKED) {                                         \
                        const int kb0 = kt * KVBLK; \
_Pragma("unroll") \
                        for (int r = 0; r < 16; ++r) { const int kv = kb0 + crow(r, hi); if (kv > qabs) p0[r] = -1e30f; if (kv + 32 > qabs) p1[r] = -1e30f; } \
                    } \
                     \
                    float a = max3f(p0[0], p0[1], p0[2]), b = max3f(p1[0], p1[1], p1[2]); \
_Pragma("unroll") \
                    for (int r = 3; r < 15; r += 2) { a = max3f(a, p0[r], p0[r + 1]); b = max3f(b, p1[r], p1[r + 1]); } \
                    float mx = max3f(a, b, fmaxf(p0[15], p1[15])); \
                    mx = fmaxf(mx, __shfl_xor(mx, 32)); \
                    if (kt == 0 || __any(mx > ATT_THR)) { \
                        const float dl = (kt == 0) ? mx : fmaxf(mx, 0.f); mrun[mp] += dl; \
                        const float alpha = __builtin_amdgcn_exp2f(-dl); lrun[mp] *= alpha; \
_Pragma("unroll") \
                        for (int r = 0; r < 16; ++r) { p0[r] -= dl; p1[r] -= dl; o[mp][0][r] *= alpha; o[mp][1][r] *= alpha; negm[mp][r] = -mrun[mp]; } \
                    } \
                    float ps = 0.f; \
_Pragma("unroll") \
                    for (int r = 0; r < 16; ++r) { p0[r] = __builtin_amdgcn_exp2f(p0[r]); p1[r] = __builtin_amdgcn_exp2f(p1[r]); ps += p0[r] + p1[r]; } \
                    lrun[mp] += ps; \
_Pragma("unroll") \
                    for (int s = 0; s < 2; ++s) { \
                        u32x4 w0, w1; \
                        w0.x = cvt_pk_bf16(p0[8 * s + 0], p0[8 * s + 1]); w0.y = cvt_pk_bf16(p0[8 * s + 2], p0[8 * s + 3]); w0.z = cvt_pk_bf16(p0[8 * s + 4], p0[8 * s + 5]); w0.w = cvt_pk_bf16(p0[8 * s + 6], p0[8 * s + 7]); \
                        w1.x = cvt_pk_bf16(p1[8 * s + 0], p1[8 * s + 1]); w1.y = cvt_pk_bf16(p1[8 * s + 2], p1[8 * s + 3]); w1.z = cvt_pk_bf16(p1[8 * s + 4], p1[8 * s + 5]); w1.w = cvt_pk_bf16(p1[8 * s + 6], p1[8 * s + 7]); \
                        pb[mp][0][s] = __builtin_bit_cast(bf16x8, w0); pb[mp][1][s] = __builtin_bit_cast(bf16x8, w1); \
                    } \
                } \
_Pragma("unroll") \
                for (int d0 = 0; d0 < 2; ++d0) \
_Pragma("unroll") \
                    for (int x = 0; x < 2; ++x) \
_Pragma("unroll") \
                        for (int s = 0; s < 2; ++s) { \
                            const s16x4 lo = vtr(buf + vro + d0 * 4096 + (32 * x + 16 * s) * 64), hh = vtr(buf + vro + d0 * 4096 + (32 * x + 16 * s + 8) * 64); \
                            const bf16x8 vf = (bf16x8){lo[0], lo[1], lo[2], lo[3], hh[0], hh[1], hh[2], hh[3]}; \
_Pragma("unroll") \
                            for (int mp = 0; mp < C::NMAP; ++mp) o[mp][d0] = __builtin_amdgcn_mfma_f32_32x32x16_bf16(vf, pb[mp][x][s], o[mp][d0], 0, 0, 0); \
                        } \
        } while (0)
        int kt = 0;
#define ATT_HEAD() ATT_ISSUE(); const LAS uchar* buf = lds + cbuf * C::BUF
#define ATT_TAIL() asm volatile("s_waitcnt vmcnt(6) lgkmcnt(0)" ::: "memory"); __builtin_amdgcn_s_barrier(); asm volatile("" ::: "memory"); cbuf = (cbuf + 1) & (NBUF - 1)
#pragma unroll 1
        for (; kt < first_band; ++kt) { ATT_HEAD(); const bool bg_ = ((tilectr++ & 7) == 0) && BG_MORE(); if (bg_) BG_LOAD(); ATT_TILE(false); if (bg_) BG_STORE(); ATT_TAIL(); }
#pragma unroll 1
        for (; kt <= last_tile; ++kt) { ATT_HEAD(); ATT_TILE(true); ATT_TAIL(); }
#pragma unroll 1
        for (; kt < cu.NT; ++kt) { ATT_ISSUE(); ATT_TAIL(); }
#undef ATT_HEAD
#undef ATT_TAIL
#undef ATT_TILE
        bf16* O3 = (bf16*)(ws + WS_O3);
#pragma unroll
        for (int mp = 0; mp < C::NMAP; ++mp) { lrun[mp] += __shfl_xor(lrun[mp], 32); const float rl = 1.0f / lrun[mp];
#pragma unroll
            for (int r = 0; r < 16; ++r) { o[mp][0][r] *= rl; o[mp][1][r] *= rl; } }
        if (MODE == 0) store_o(O3 + tq * O3_LD + cu.h * 64, o[0], hi);
        else {
            const float* subln = (const float*)ldptr(pt, I_SUBLN) + l * 64;
            float ss = 0.f;
#pragma unroll
            for (int d0 = 0; d0 < 2; ++d0)
#pragma unroll
                for (int r = 0; r < 16; ++r) { const float v = o[0][d0][r] - lam_val * o[C::NMAP - 1][d0][r]; o[0][d0][r] = v; ss += v * v; }
            ss += __shfl_xor(ss, 32);
            const float rs = rsqrtf(ss * (1.0f / 64.0f) + 1e-5f) * (1.0f - lam_init);
#pragma unroll
            for (int d0 = 0; d0 < 2; ++d0)
#pragma unroll
                for (int r = 0; r < 16; ++r) o[0][d0][r] *= rs * subln[d0 * 32 + crow(r, hi)];
            store_o(O3 + tq * O3_LD + 512 + cu.h * 64, o[0], hi);
        }
        ++ci;
        if (!unit_params<MODE>(ci, G, c, ws, cu)) break;
    }
    while (BG_MORE()) { BG_LOAD(); BG_STORE(); }
    asm volatile("s_waitcnt vmcnt(0)" ::: "memory"); __builtin_amdgcn_s_barrier(); asm volatile("" ::: "memory");
#undef BG_MORE
#undef BG_LOAD
#undef BG_STORE
#undef ATT_ISSUE
}
#undef ATT_THR
}
template <class ColPtr>
__device__ __forceinline__ void xpose_item(const ColPtr& cp, int ldw, int ksrc, const float* kscale, bf16* WT, int Kd, int item, int nblk, LAS float* scr, int lane) {
    const int kb = item / nblk, nb = item % nblk, k0 = 64 * kb, n0 = 32 * nb;
    const float* src = cp(n0 + (lane & 31));
#pragma unroll 8
    for (int i = 0; i < 32; ++i) { const int kk = 2 * i + (lane >> 5), k = k0 + kk; float v = 0.f;
        if (src != nullptr && k < ksrc) { v = src[(size_t)k * ldw]; if (kscale) v *= kscale[k]; }
        scr[kk * 33 + (lane & 31)] = v; }
    LDS_WAIT(); asm volatile("" ::: "memory");
    const int c = lane & 7;
#pragma unroll
    for (int j = 0; j < 4; ++j) { const int n = (lane >> 3) + 8 * j; const LAS float* s = scr + (8 * c) * 33 + n;
        u32x4 o; o.x = pk2(s[0 * 33], s[1 * 33]); o.y = pk2(s[2 * 33], s[3 * 33]); o.z = pk2(s[4 * 33], s[5 * 33]); o.w = pk2(s[6 * 33], s[7 * 33]);
        *(u32x4*)(WT + (size_t)(n0 + n) * Kd + k0 + 8 * c) = o; }
    LDS_WAIT(); asm volatile("" ::: "memory");
}
__device__ __forceinline__ void xpose64(const float* src, int ldw, int ksrc, const float* kscale, bf16* WT, int Kd, int n0, int k0, int lane) {
    const int c = lane & 15, kr = lane >> 4, kb = k0 + 16 * kr;
    f32x4 v[16];
    if (src != nullptr && kb < ksrc) {
#pragma unroll
        for (int j = 0; j < 16; ++j) v[j] = *(const f32x4*)(src + (size_t)(kb + j) * ldw + 4 * c);
        if (kscale) {
#pragma unroll
            for (int j = 0; j < 16; ++j) v[j] *= kscale[kb + j];
        }
    } else {
#pragma unroll
        for (int j = 0; j < 16; ++j) v[j] = (f32x4){0.f, 0.f, 0.f, 0.f};
    }
#pragma unroll
    for (int i = 0; i < 4; ++i) { bf16* row = WT + (size_t)(n0 + 4 * c + i) * Kd + kb;
#pragma unroll
        for (int h = 0; h < 2; ++h) { u32x4 o; o.x = pk2(v[8 * h + 0][i], v[8 * h + 1][i]); o.y = pk2(v[8 * h + 2][i], v[8 * h + 3][i]); o.z = pk2(v[8 * h + 4][i], v[8 * h + 5][i]); o.w = pk2(v[8 * h + 6][i], v[8 * h + 7][i]);
            *(u32x4*)(row + 8 * h) = o; } }
}
__device__ __forceinline__ int rope_perm(int j) { return (j & 1) ? 16 + (j >> 1) : (j >> 1); }
struct CpWin { const float* W; __device__ __forceinline__ const float* operator()(int n) const {
    if (n < 512) return W + 416 + n; if (n < 1024) return W + 928 + (n - 512); if (n < 1536) return W + 1440 + (n - 1024); if (n < 1792) return W + (n - 1536);
    if (n < 1920) return W + 256 + (n - 1792); if (n < 1952) return W + 384 + rope_perm(n - 1920); if (n < 2048) return nullptr; return W + 1952 + (n - 2048); } };
struct CpOff { const float* W; __device__ __forceinline__ const float* operator()(int n) const { return W + n; } };
struct CpWuq { const float* W; __device__ __forceinline__ const float* operator()(int n) const { const int h = n / 96, c = n % 96; return W + h * 96 + (c < 64 ? c : 64 + rope_perm(c - 64)); } };
struct CpGlu { const float* W; __device__ __forceinline__ const float* operator()(int n) const { const int nt = n >> 8, i = n & 255; return W + (i < 128 ? 128 * nt + i : 1024 + 128 * nt + (i - 128)); } };
struct CpMoe1 { const float* Wg; const float* Wu; __device__ __forceinline__ const float* operator()(int n) const { const int nt = n >> 8, i = n & 255; return i < 128 ? Wg + 128 * nt + i : Wu + 128 * nt + (i - 128); } };

__device__ __forceinline__ void moe_colmax_pass(PT pt, int l, int vcu, int G) {
    const int tid = ltid(), lane = tid & 63, wave = __builtin_amdgcn_readfirstlane(tid >> 6), cc = lane & 15, kr = lane >> 4;
    uchar* ws = (uchar*)ldptr(pt, I_WS); float* mcm = (float*)(ws + WS_MCM);
    const float* mo_g = (const float*)ldptr(pt, I_MG) + (size_t)l * 32 * 1024 * 512; const float* mo_u = (const float*)ldptr(pt, I_MU) + (size_t)l * 32 * 1024 * 512;
    for (int g = vcu * 8 + wave; g < 32 * 512; g += G * 8) {
        const int e = g >> 9, r = g & 511, nb = r & 15, k0 = (r >> 4) * 32, n0 = nb * 64, nt = n0 >> 8, i = n0 & 255;
        const float* src = (i < 128 ? mo_g + 128 * nt + i : mo_u + 128 * nt + (i - 128)) + (size_t)e * 1024 * 512;
        f32x4 v[8];
#pragma unroll
        for (int j = 0; j < 8; ++j) v[j] = *(const f32x4*)(src + (size_t)(k0 + 8 * kr + j) * 512 + 4 * cc);
        float* cm = mcm + (size_t)(l * 32 + e) * 1024 + n0 + 4 * cc;
#pragma unroll
        for (int q = 0; q < 4; ++q) { float x = fabsf(v[0][q]);
#pragma unroll
            for (int j = 1; j < 8; ++j) x = fmaxf(x, fabsf(v[j][q]));
            x = fmaxf(x, __shfl_xor(x, 16)); x = fmaxf(x, __shfl_xor(x, 32));
            if (lane < 16) atomicMax((int*)(cm + q), __float_as_int(x)); }
    }
}
__device__ __forceinline__ void quant_row(uchar* ws, int t, const float (&v)[16], int lane) {
    float m = 0.f;
#pragma unroll
    for (int j = 0; j < 16; ++j) m = fmaxf(m, fabsf(v[j]));
    m = fmaxf(wave_max(m), 1e-30f); const float inv = 127.0f / m;
    uchar* row = (t < XQ_SPLIT * 256) ? ws + WS_XQ1 + (size_t)t * 1024 : ws + WS_XQ2 + (size_t)(t - XQ_SPLIT * 256) * 1024;
    u32x2 a, b; a.x = pack4_i8(v[0] * inv, v[1] * inv, v[2] * inv, v[3] * inv); a.y = pack4_i8(v[4] * inv, v[5] * inv, v[6] * inv, v[7] * inv);
    b.x = pack4_i8(v[8] * inv, v[9] * inv, v[10] * inv, v[11] * inv); b.y = pack4_i8(v[12] * inv, v[13] * inv, v[14] * inv, v[15] * inv);
    *(u32x2*)(row + 8 * lane) = a; *(u32x2*)(row + 512 + 8 * lane) = b;
    if (lane == 0) ((float*)(ws + WS_XRS))[t] = m * (1.0f / 127.0f);
}
__device__ __forceinline__ void prep_phase(PT pt, int l, LAS uchar* lds, int vcu, int G) {
    const int tid = ltid(), lane = tid & 63, wave = __builtin_amdgcn_readfirstlane(tid >> 6);
    uchar* ws = (uchar*)ldptr(pt, I_WS);
    {
        LAS f32x2* apow = (LAS f32x2*)lds;
        LAS f32x2* bbar = apow + 17 * 64;
        LAS f32x2* cm = bbar + 64 * 16;
        LAS float* kk = (LAS float*)(cm + 16 * 64);
        const float* are = (const float*)ldptr(pt, I_ARE) + (size_t)l * 32 * 64; const float* aim = (const float*)ldptr(pt, I_AIM) + (size_t)l * 32 * 64; const float* ldt = (const float*)ldptr(pt, I_LOGDT) + l * 32;
        const float* bre = (const float*)ldptr(pt, I_BRE) + (size_t)l * 32 * 1024; const float* bim = (const float*)ldptr(pt, I_BIM) + (size_t)l * 32 * 1024;
        const float* cre = (const float*)ldptr(pt, I_CRE) + (size_t)l * 32 * 1024; const float* cim = (const float*)ldptr(pt, I_CIM) + (size_t)l * 32 * 1024;
        for (int g = vcu; g < 32; g += G) {
            const float dt = expf(ldt[g]);
            for (int i = tid; i < 17 * 64; i += 512) { const int k = i >> 6, n = i & 63; const float ar = are[g * 64 + n] * dt * (float)k, ai = aim[g * 64 + n] * dt * (float)k; const float e = expf(ar); float sn, cs; sincosf(ai, &sn, &cs); apow[i] = (f32x2){e * cs, e * sn}; }
            for (int i = tid; i < 1024; i += 512) { const int n = i >> 4;
                const float Ar = are[g * 64 + n], Ai = aim[g * 64 + n]; const float e = expf(Ar * dt); float sn, cs; sincosf(Ai * dt, &sn, &cs);
                const float nr = e * cs - 1.0f, ni = e * sn, den = 1.0f / (Ar * Ar + Ai * Ai); const float fr_ = (nr * Ar + ni * Ai) * den, fi_ = (ni * Ar - nr * Ai) * den;
                const float br = bre[g * 1024 + i], bi = bim[g * 1024 + i]; bbar[i] = (f32x2){fr_ * br - fi_ * bi, fr_ * bi + fi_ * br};
                cm[i] = (f32x2){cre[g * 1024 + i], cim[g * 1024 + i]}; }
            __syncthreads();
            for (int i = tid; i < 4096; i += 512) { const int k = i >> 8, p = (i >> 4) & 15, q = i & 15; float s = 0.f;
                for (int n = 0; n < 64; ++n) { const f32x2 c = cm[p * 64 + n], ak = apow[k * 64 + n], b = bbar[n * 16 + q]; const float zr = c.x * ak.x - c.y * ak.y, zi = c.x * ak.y + c.y * ak.x; s += zr * b.x - zi * b.y; }
                kk[i] = s; }
            __syncthreads();
            bf16* wy = (bf16*)(ws + W_SY) + (size_t)g * 256 * 384; bf16* wsm = (bf16*)(ws + W_SS) + (size_t)g * 256 * 256;
            for (int i = tid; i < 256 * 384 / 2; i += 512) { const int row = (2 * i) / 384, k0 = (2 * i) % 384; const int ii = row >> 4, p = row & 15; float v[2];
#pragma unroll
                for (int e = 0; e < 2; ++e) { const int k = k0 + e;
                    if (k < 256) { const int j = k >> 4, q = k & 15; v[e] = (j <= ii) ? kk[((ii - j) * 16 + p) * 16 + q] : 0.f; }
                    else { const int n = (k - 256) & 63; const f32x2 c = cm[p * 64 + n], ak = apow[(ii + 1) * 64 + n]; v[e] = (k < 320) ? (c.x * ak.x - c.y * ak.y) : -(c.x * ak.y + c.y * ak.x); } }
                *(unsigned*)(wy + (size_t)row * 384 + k0) = pk2(v[0], v[1]); }
            for (int i = tid; i < 256 * 256 / 2; i += 512) { const int row = (2 * i) >> 8, k0 = (2 * i) & 255; float v[2];
#pragma unroll
                for (int e = 0; e < 2; ++e) { const int k = k0 + e, j = k >> 4, q = k & 15;
                    if (row < 128) { const int n = row >> 1; const f32x2 ak = apow[(15 - j) * 64 + n], b = bbar[n * 16 + q]; v[e] = (row & 1) ? (ak.x * b.y + ak.y * b.x) : (ak.x * b.x - ak.y * b.y); } else v[e] = 0.f; }
                *(unsigned*)(wsm + (size_t)row * 256 + k0) = pk2(v[0], v[1]); }
            if (tid < 64) ((f32x2*)(ws + WS_A16))[g * 64 + tid] = apow[16 * 64 + tid];
            __syncthreads();
        }
    }
    {
        const float* win_ = (const float*)ldptr(pt, I_WIN) + (size_t)l * 1024 * IN_WIDTH;
        LAS float* cmx = (LAS float*)lds;
        const int c = tid & 63, kq = tid >> 6;
        for (int cb = (vcu + G - (32 % G)) % G; cb < 48 + 40; cb += G) {
            const bool gate = cb < 48; const int n = (gate ? cb : cb - 48) * 64 + c;
            const float* src = gate ? win_ + 2464 + n : CpWin{win_}(n); float mx = 0.f;
            if (src) for (int k = kq * 128; k < kq * 128 + 128; ++k) mx = fmaxf(mx, fabsf(src[(size_t)k * IN_WIDTH]));
            cmx[kq * 64 + c] = mx;
            __syncthreads();
            float m = cmx[c];
#pragma unroll
            for (int q = 1; q < 8; ++q) m = fmaxf(m, cmx[q * 64 + c]);
            m = fmaxf(m, 1e-30f); const float inv = 127.0f / m;
            if (kq == 0) ((float*)(ws + (gate ? WS_GCS : WS_ICS)))[n] = m * (1.0f / 127.0f);
            uchar* dst = ws + (gate ? W_G : W_IN) + (size_t)n * 1024 + kq * 128;
            for (int k0 = 0; k0 < 128; k0 += 16) { u32x4 o; unsigned w[4];
#pragma unroll
                for (int q = 0; q < 4; ++q) { if (src) { const float* s4 = src + (size_t)(kq * 128 + k0 + 4 * q) * IN_WIDTH; w[q] = pack4_i8(s4[0] * inv, s4[IN_WIDTH] * inv, s4[2 * (size_t)IN_WIDTH] * inv, s4[3 * (size_t)IN_WIDTH] * inv); } else w[q] = 0u; }
                o.x = w[0]; o.y = w[1]; o.z = w[2]; o.w = w[3]; *(u32x4*)(dst + k0) = o; }
            __syncthreads();
        }
    }
    {
        LAS float* scr = (LAS float*)(lds + wave * 16384);
        const int gw = vcu * 8 + wave, NGW = G * 8;
        const float* win = (const float*)ldptr(pt, I_WIN) + (size_t)l * 1024 * IN_WIDTH;
        constexpr int F0 = 0, F1 = 0  , F3 = 2 * 16, F4 = 8 * 16, F5 = 8 * 16, F6 = 8 * 32, F7 = 16 * 16, S2 = 4 * 24, S0 = 0;
        constexpr int NIT = F0 + F1 + F3 + F4 + F5 + F6 + F7 + S2 + S0;
        for (int it = gw; it < NIT; it += NGW) { int r = it;
            if (r < F0) { const int kb = r / 40, nb = r % 40; if (nb != 30) xpose64(CpWin{win}(nb * 64), IN_WIDTH, 1024, nullptr, (bf16*)(ws + W_IN), 1024, nb * 64, kb * 64, lane); continue; } r -= F0;
            if (r < F1) { const int kb = r / 48, nb = r % 48; xpose64(win + 2464 + nb * 64, IN_WIDTH, 1024, nullptr, (bf16*)(ws + W_G), 1024, nb * 64, kb * 64, lane); continue; } r -= F1;
            if (r < F3) { const int kb = r / 16, nb = r % 16; xpose64((const float*)ldptr(pt, I_WUKV) + (size_t)l * 128 * 1024 + nb * 64, 1024, 128, (const float*)ldptr(pt, I_KVNORM) + l * 128, (bf16*)(ws + W_UKV), 128, nb * 64, kb * 64, lane); continue; } r -= F3;
            if (r < F4) { const int kb = r / 16, nb = r % 16; xpose64((const float*)ldptr(pt, I_WAOUT) + (size_t)l * 512 * 1024 + nb * 64, 1024, 512, nullptr, (bf16*)(ws + W_A), 1024, nb * 64, kb * 64, lane); continue; } r -= F4;
            if (r < F5) { const int kb = r / 16, nb = r % 16; xpose64((const float*)ldptr(pt, I_WBOUT) + (size_t)l * 512 * 1024 + nb * 64, 1024, 512, nullptr, (bf16*)(ws + W_A) + 512, 1024, nb * 64, kb * 64, lane); continue; } r -= F5;
            if (r < F6) { const int kb = r / 32, nb = r % 32; xpose64(CpGlu{(const float*)ldptr(pt, I_WGLU) + (size_t)l * 512 * 2048}(nb * 64), 2048, 512, nullptr, (bf16*)(ws + W_GLU2), 1024, nb * 64, kb * 64, lane); continue; } r -= F6;
            if (r < F7) { const int kb = r / 16, nb = r % 16; xpose64((const float*)ldptr(pt, I_WO) + (size_t)l * 1024 * 1024 + nb * 64, 1024, 1024, nullptr, (bf16*)(ws + W_O), 1024, nb * 64, kb * 64, lane); continue; } r -= F7;
            if (r < S2) { xpose_item(CpWuq{(const float*)ldptr(pt, I_WUQ) + (size_t)l * 256 * 768}, 768, 256, (const float*)ldptr(pt, I_QNORM) + l * 256, (bf16*)(ws + W_UQ), 256, r, 24, scr, lane); continue; } r -= S2;
        }
    }
    if (l == 0) {
        const float* x = (const float*)ldptr(pt, I_X); bf16* xb = (bf16*)(ws + WS_XB);
        const size_t stride = (size_t)G * 512;
        for (int t = vcu * 8 + wave; t < T; t += G * 8) { float v[16];
#pragma unroll
            for (int hf = 0; hf < 2; ++hf) { const float* xr = x + (size_t)t * 1024 + hf * 512 + 8 * lane; const f32x4 v0 = *(const f32x4*)xr, v1 = *(const f32x4*)(xr + 4);
                u32x4 o; o.x = pk2(v0[0], v0[1]); o.y = pk2(v0[2], v0[3]); o.z = pk2(v1[0], v1[1]); o.w = pk2(v1[2], v1[3]); *(u32x4*)(xb + (size_t)t * 1024 + hf * 512 + 8 * lane) = o;
#pragma unroll
                for (int j = 0; j < 4; ++j) { v[hf * 8 + j] = v0[j]; v[hf * 8 + 4 + j] = v1[j]; } }
            quant_row(ws, t, v, lane); }
        { const float* rw = (const float*)ldptr(pt, I_RW); bf16* rwh = (bf16*)(ws + WS_RWH); bf16* rwl = (bf16*)(ws + WS_RWL);
          for (size_t i = (size_t)vcu * 512 + tid; i < 32 * 1024; i += stride) { const int e = (int)(i >> 10), k = (int)(i & 1023); const float w = rw[k * 32 + e]; const unsigned h = f2bf(w); rwh[i] = (bf16)h; rwl[i] = (bf16)f2bf(w - __uint_as_float(h << 16)); } }
        const int* pos = (const int*)ldptr(pt, I_POS); f32x2* ra = (f32x2*)(ws + WS_ROPEA); f32x2* rb = (f32x2*)(ws + WS_ROPEB);
        for (size_t i = (size_t)vcu * 512 + tid; i < (size_t)T * 20; i += stride) { const int t = (int)(i / 20), j = (int)(i % 20);
            const float p = (float)pos[t]; float inv; if (j < 16) inv = powf(500000.0f, -(float)(2 * j) / 32.0f); else inv = powf(500000.0f, -(float)(2 * (j - 16)) / 8.0f);
            const float ang = p * inv; float sn, cs; sincosf(ang, &sn, &cs);
            if (j < 16) ra[(size_t)t * 16 + j] = (f32x2){cs, sn}; else rb[(size_t)t * 4 + (j - 16)] = (f32x2){cs, sn}; }
    }
}
__device__ __forceinline__ void prep_moe(PT pt, int l, LAS uchar* lds, int vcu, int G) {
    const int tid = ltid(), lane = tid & 63, wave = __builtin_amdgcn_readfirstlane(tid >> 6);
    LAS float* scr = (LAS float*)(lds + wave * 16384);
    const int gw = vcu * 8 + wave, NGW = G * 8;
    const float* wg = (const float*)ldptr(pt, I_MG) + (size_t)l * 32 * 1024 * 512; const float* wu = (const float*)ldptr(pt, I_MU) + (size_t)l * 32 * 1024 * 512; const float* wd = (const float*)ldptr(pt, I_MD) + (size_t)l * 32 * 512 * 1024;
    constexpr int J1 = 16 * 16, J2 = 8 * 16;
    for (int it = gw; it < 32 * (J1 + J2); it += NGW) {
        if (it < 32 * J1) { const int e = it / J1, r = it % J1, kb = r / 16, nb = r % 16; xpose64(CpMoe1{wg + (size_t)e * 1024 * 512, wu + (size_t)e * 1024 * 512}(nb * 64), 512, 1024, nullptr, (bf16*)(((uchar*)ldptr(pt, I_WS)) + WS_WM1) + (size_t)e * 1024 * 1024, 1024, nb * 64, kb * 64, lane); }
        else { const int e = (it - 32 * J1) / J2, r = (it - 32 * J1) % J2, kb = r / 16, nb = r % 16; xpose64(wd + (size_t)e * 512 * 1024 + nb * 64, 1024, 512, nullptr, (bf16*)(((uchar*)ldptr(pt, I_WS)) + WS_WM2) + (size_t)e * 1024 * 512, 512, nb * 64, kb * 64, lane); }
    }
}

__device__ __forceinline__ void scan_phase(PT pt, int vcu, int G) {
    const int tid = ltid(), lane = tid & 63, wave = __builtin_amdgcn_readfirstlane(tid >> 6);
    const unsigned* S = (const unsigned*)(((uchar*)ldptr(pt, I_WS)) + WS_S); bf16* UC = (bf16*)(((uchar*)ldptr(pt, I_WS)) + WS_UC); const f32x2* A16 = (const f32x2*)(((uchar*)ldptr(pt, I_WS)) + WS_A16);
    for (int task = vcu + G * wave; task < 512; task += G * 8) {
        const int b = task >> 5, g = task & 31;
        const f32x2 aa = A16[g * 64 + lane]; float hr = 0.f, hi_ = 0.f;
        const size_t row0 = (size_t)g * NCHUNK + (size_t)b * 256;
        unsigned s0[32], s1[32];
#define SC_LOAD(SV, C0) _Pragma("unroll") for (int j = 0; j < 32; ++j) SV[j] = S[(row0 + (C0) + j) * 64 + lane];
#define SC_STEPS(SV, C0) _Pragma("unroll") for (int j = 0; j < 32; ++j) { bf16* up = UC + (row0 + (C0) + j) * UC_LD + 256 + lane; up[0] = (bf16)f2bf(hr); up[64] = (bf16)f2bf(hi_); \
                const float nr = aa.x * hr - aa.y * hi_ + bflo(SV[j]), ni = aa.x * hi_ + aa.y * hr + bfhi(SV[j]); hr = nr; hi_ = ni; }
        SC_LOAD(s0, 0);
#pragma unroll 1
        for (int c0 = 0; c0 < 256; c0 += 64) {
            SC_LOAD(s1, c0 + 32);
            SC_STEPS(s0, c0);
            if (c0 + 64 < 256) { SC_LOAD(s0, c0 + 64); }
            SC_STEPS(s1, c0 + 32);
        }
#undef SC_LOAD
#undef SC_STEPS
    }
}

__device__ __forceinline__ void attn_phase(PT pt, int l, LAS uchar* lds, int c, int G, int vcu) {
    attn::attn_stream<0>(pt, l, lds, c, G, vcu);
    attn::attn_stream<1>(pt, l, lds, c, G, vcu);
}
constexpr int RW_ROW = 1040;
__device__ __forceinline__ void ln1_router_phase(PT pt, int l, LAS uchar* lds, int vcu, int G) {
    const int tid = ltid(), lane = tid & 63, r32 = lane & 31, hi = lane >> 5, wave = __builtin_amdgcn_readfirstlane(tid >> 6);
    uchar* ws = (uchar*)ldptr(pt, I_WS);
    const bf16* Z = (const bf16*)(ws + WS_Z); bf16* XB = (bf16*)(ws + WS_XB);
    const float* gain = (const float*)ldptr(pt, I_LNG) + (size_t)(l * 2 + 0) * 1024; const float* bias = (const float*)ldptr(pt, I_LNB) + (size_t)(l * 2 + 0) * 1024;
    const float* rbias = (const float*)ldptr(pt, I_RB);
    const bf16* RWH = (const bf16*)(ws + WS_RWH); const bf16* RWL = (const bf16*)(ws + WS_RWL);
    int* toke = (int*)(ws + WS_TOKE); float* tokw = (float*)(ws + WS_TOKW); int* tokp = (int*)(ws + WS_TOKP); int* rowtok = (int*)(ws + WS_ROWTOK);
    unsigned* cnt = (unsigned*)(ws + WS_CTL) + CW_CNT + l * 32;
    LAS unsigned* hist = (LAS unsigned*)(lds + MISC_OFF + MO_HIST); LAS unsigned* base = (LAS unsigned*)(lds + MISC_OFF + MO_BASE);
    LAS int* pe = (LAS int*)(lds + MISC_OFF + MO_PE); LAS int* pr = (LAS int*)(lds + MISC_OFF + MO_PR);
    for (int panel = vcu; panel < T / 256; panel += G) {
        if (tid < 32) hist[tid] = 0u;
        for (int bt = 0; bt < 8; ++bt) {
            const int row0 = panel * 256 + wave * 32 + bt * 4;
#pragma unroll
            for (int r = 0; r < 4; ++r) {
                const bf16* zr = Z + (size_t)(row0 + r) * 1024; const u32x4 w0 = *(const u32x4*)(zr + 8 * lane), w1 = *(const u32x4*)(zr + 512 + 8 * lane);
                float v[16] = {bflo(w0.x), bfhi(w0.x), bflo(w0.y), bfhi(w0.y), bflo(w0.z), bfhi(w0.z), bflo(w0.w), bfhi(w0.w), bflo(w1.x), bfhi(w1.x), bflo(w1.y), bfhi(w1.y), bflo(w1.z), bfhi(w1.z), bflo(w1.w), bfhi(w1.w)};
                float s = 0.f;
#pragma unroll
                for (int j = 0; j < 16; ++j) s += v[j];
                const float mu = wave_sum(s) * (1.0f / 1024.0f); float q2 = 0.f;
#pragma unroll
                for (int j = 0; j < 16; ++j) { v[j] -= mu; q2 += v[j] * v[j]; }
                const float rstd = rsqrtf(wave_sum(q2) * (1.0f / 1024.0f) + LN_EPS);
                float y[16];
#pragma unroll
                for (int hf = 0; hf < 2; ++hf) { const int eo = hf * 512 + 8 * lane; const f32x4 g0 = *(const f32x4*)(gain + eo), g1 = *(const f32x4*)(gain + eo + 4), b0 = *(const f32x4*)(bias + eo), b1 = *(const f32x4*)(bias + eo + 4);
#pragma unroll
                    for (int j = 0; j < 4; ++j) { y[hf * 8 + j] = v[hf * 8 + j] * rstd * g0[j] + b0[j]; y[hf * 8 + 4 + j] = v[hf * 8 + 4 + j] * rstd * g1[j] + b1[j]; } }
                bf16* xr = XB + (size_t)(row0 + r) * 1024;
                u32x4 o0, o1; o0.x = pk2(y[0], y[1]); o0.y = pk2(y[2], y[3]); o0.z = pk2(y[4], y[5]); o0.w = pk2(y[6], y[7]);
                o1.x = pk2(y[8], y[9]); o1.y = pk2(y[10], y[11]); o1.z = pk2(y[12], y[13]); o1.w = pk2(y[14], y[15]);
                *(u32x4*)(xr + 8 * lane) = o0; *(u32x4*)(xr + 512 + 8 * lane) = o1;
                quant_row(ws, row0 + r, y, lane);
            }
        }
        f32x16 acc = f32x16{};
        const bf16* yrow = XB + (size_t)(panel * 256 + wave * 32 + r32) * 1024 + hi * 8;
        for (int half = 0; half < 2; ++half) {
            __syncthreads();
            for (int i = tid; i < 2 * 32 * 64; i += 512) { const int which = i >> 11, row = (i >> 6) & 31, pc = i & 63;
                *(LAS u32x4*)(lds + which * (32 * RW_ROW) + row * RW_ROW + pc * 16) = *(const u32x4*)((which ? RWL : RWH) + (size_t)row * 1024 + half * 512 + pc * 8); }
            __syncthreads();
#pragma unroll 8
            for (int s = 0; s < 32; ++s) {
                const bf16x8 yf = *(const bf16x8*)(yrow + half * 512 + s * 16);
                const bf16x8 ah = *(const LAS bf16x8*)(lds + r32 * RW_ROW + s * 32 + hi * 16), al = *(const LAS bf16x8*)(lds + 32 * RW_ROW + r32 * RW_ROW + s * 32 + hi * 16);
                acc = __builtin_amdgcn_mfma_f32_32x32x16_bf16(ah, yf, acc, 0, 0, 0);
                acc = __builtin_amdgcn_mfma_f32_32x32x16_bf16(al, yf, acc, 0, 0, 0);
            }
        }
        {
            const int t = panel * 256 + wave * 32 + r32;
            float sc[16], bz[16];
#pragma unroll
            for (int r = 0; r < 16; ++r) { sc[r] = 1.0f / (1.0f + __expf(-acc[r])); bz[r] = sc[r] + rbias[(r & 3) + 8 * (r >> 2) + 4 * hi]; }
            float best = -1e30f; int bk = 0;
#pragma unroll
            for (int k = 0; k < 4; ++k) { float m1 = -1e30f, m2 = -1e30f;
#pragma unroll
                for (int j = 0; j < 4; ++j) { const float v = bz[4 * k + j]; if (v > m1) { m2 = m1; m1 = v; } else if (v > m2) m2 = v; }
                const float gs = m1 + m2; if (gs > best) { best = gs; bk = k; } }
            const int gid = 2 * bk + hi; const float pbest = __shfl_xor(best, 32); const int pgid = __shfl_xor(gid, 32);
            const bool win = (best > pbest) || (best == pbest && gid < pgid);
            if (win) {
                float v0 = -1e30f, v1 = -1e30f, s0 = 0.f, s1 = 0.f; int i0 = 0, i1 = 0;
#pragma unroll
                for (int k = 0; k < 4; ++k) if (k == bk) {
#pragma unroll
                    for (int j = 0; j < 4; ++j) { const float v = bz[4 * k + j], s = sc[4 * k + j]; const int e = 8 * k + 4 * hi + j;
                        if (v > v0) { v1 = v0; i1 = i0; s1 = s0; v0 = v; i0 = e; s0 = s; } else if (v > v1) { v1 = v; i1 = e; s1 = s; } } }
                const float inv = 1.0f / (s0 + s1);
                toke[t * 2] = i0; toke[t * 2 + 1] = i1; tokw[t * 2] = s0 * inv; tokw[t * 2 + 1] = s1 * inv;
                const int tl = (t & 255) * 2; pe[tl] = i0; pe[tl + 1] = i1; pr[tl] = (int)atomicAdd((unsigned*)&hist[i0], 1u); pr[tl + 1] = (int)atomicAdd((unsigned*)&hist[i1], 1u);
            }
        }
        __syncthreads();
        if (tid < 32) base[tid] = atomicAdd(cnt + tid, hist[tid]);
        __syncthreads();
        { const int e = pe[tid], pos = pr[tid] + (int)base[e]; tokp[panel * 512 + tid] = pos; const int tk = panel * 256 + (tid >> 1); rowtok[(size_t)e * ECAP + pos] = tk + (tk >= XQ_SPLIT * 256 ? XQ_VOFF : 0); }
        __syncthreads();
    }
}
__device__ __forceinline__ void moe_tables(PT pt, int l, LAS uchar* lds) {
    LAS int* pads = (LAS int*)(lds + MISC_OFF + MO_PADS); LAS int* mts = (LAS int*)(lds + MISC_OFF + MO_MTS);
    if (threadIdx.x == 0) { const unsigned* cnt = (const unsigned*)(((uchar*)ldptr(pt, I_WS)) + WS_CTL) + CW_CNT + l * 32; int acc = 0;
        for (int e = 0; e < 32; ++e) { mts[e] = acc; pads[e] = acc * 256; acc += (int)((cnt[e] + 255u) >> 8); } mts[32] = acc; pads[32] = acc * 256; }
    __syncthreads();
}
struct MoeSched {
    int G, c; const LAS int* mts; const char* Ab; size_t a_tile; const char* Wb; size_t w_exp, w_nt; const int* rowtok; int c_step;
    __device__ __forceinline__ bool next(int i, pg8::Unit& u) const {
        const int L = i * G + c; const int MT = __builtin_amdgcn_readfirstlane(mts[32]); if (L >= MT * 4) return false;
        const int mt = L >> 2, nt = L & 3; int e = 0;
        for (int j = 1; j < 32; ++j) e += (mt >= mts[j]) ? 1 : 0;
        e = __builtin_amdgcn_readfirstlane(e);
        u.A = Ab + (size_t)mt * a_tile; u.B = Wb + (size_t)e * w_exp + (size_t)nt * w_nt; u.rows = rowtok + (size_t)e * ECAP + (mt - __builtin_amdgcn_readfirstlane(mts[e])) * 256; u.r0 = mt * 256; u.c0 = nt * c_step; u.aux = e; return true;
    }
};
__device__ __forceinline__ void ln2_phase(PT pt, int l, LAS uchar* lds, int vcu, int G) {
    moe_tables(pt, l, lds);
    const LAS int* pads = (const LAS int*)(lds + MISC_OFF + MO_PADS);
    const int tid = ltid(), lane = tid & 63, wave = __builtin_amdgcn_readfirstlane(tid >> 6);
    uchar* ws = (uchar*)ldptr(pt, I_WS); bf16* XB = (bf16*)(ws + WS_XB); const uchar* YB = (const uchar*)(ws + WS_YB);
    const int* toke = (const int*)(ws + WS_TOKE); const int* tokp = (const int*)(ws + WS_TOKP); const float* tokw = (const float*)(ws + WS_TOKW);
    const float* gain = (const float*)ldptr(pt, I_LNG) + (size_t)(l * 2 + 1) * 1024; const float* bias = (const float*)ldptr(pt, I_LNB) + (size_t)(l * 2 + 1) * 1024;
    float gn[16], bs[16];
#pragma unroll
    for (int j = 0; j < 16; ++j) { const int e = (j < 8) ? 8 * lane + j : 512 + 8 * lane + (j - 8); gn[j] = gain[e]; bs[j] = bias[e]; }
    for (int tb = vcu * 8 + wave; tb < T; tb += G * 8 * 64) {
        const int tj = tb + lane * G * 8; int sl0 = 0, sl1 = 0; float wl0 = 0.f, wl1 = 0.f;
        if (tj < T) { sl0 = pads[toke[tj * 2]] + tokp[tj * 2]; sl1 = pads[toke[tj * 2 + 1]] + tokp[tj * 2 + 1]; wl0 = tokw[tj * 2]; wl1 = tokw[tj * 2 + 1]; }
      for (int j = 0; j < 64; ++j) { const int t = tb + j * G * 8; if (t >= T) break;
        const int s0 = __builtin_amdgcn_readlane(sl0, j), s1 = __builtin_amdgcn_readlane(sl1, j); const float w0 = __builtin_bit_cast(float, __builtin_amdgcn_readlane(__builtin_bit_cast(int, wl0), j)), w1 = __builtin_bit_cast(float, __builtin_amdgcn_readlane(__builtin_bit_cast(int, wl1), j));
        float v[16];
#pragma unroll
        for (int hf = 0; hf < 2; ++hf) { const int off = hf * 512 + 8 * lane;
            const u32x4 xw = *(const u32x4*)(XB + (size_t)t * 1024 + off); const u32x2 ya = *(const u32x2*)(YB + (size_t)s0 * 1024 + off), yb = *(const u32x2*)(YB + (size_t)s1 * 1024 + off);
            const unsigned xs[4] = {xw.x, xw.y, xw.z, xw.w}; const int as[2] = {(int)ya.x, (int)ya.y}, bs_[2] = {(int)yb.x, (int)yb.y};
            const f32x2 fa[4] = {__builtin_amdgcn_cvt_pk_f32_fp8(as[0], false), __builtin_amdgcn_cvt_pk_f32_fp8(as[0], true), __builtin_amdgcn_cvt_pk_f32_fp8(as[1], false), __builtin_amdgcn_cvt_pk_f32_fp8(as[1], true)};
            const f32x2 fb[4] = {__builtin_amdgcn_cvt_pk_f32_fp8(bs_[0], false), __builtin_amdgcn_cvt_pk_f32_fp8(bs_[0], true), __builtin_amdgcn_cvt_pk_f32_fp8(bs_[1], false), __builtin_amdgcn_cvt_pk_f32_fp8(bs_[1], true)};
#pragma unroll
            for (int j = 0; j < 4; ++j) { v[hf * 8 + 2 * j] = DN_ALPHA * bflo(xs[j]) + w0 * fa[j][0] + w1 * fb[j][0]; v[hf * 8 + 2 * j + 1] = DN_ALPHA * bfhi(xs[j]) + w0 * fa[j][1] + w1 * fb[j][1]; } }
        float s = 0.f;
#pragma unroll
        for (int j = 0; j < 16; ++j) s += v[j];
        const float mu = wave_sum(s) * (1.0f / 1024.0f); float q = 0.f;
#pragma unroll
        for (int j = 0; j < 16; ++j) { v[j] -= mu; q += v[j] * v[j]; }
        const float rstd = rsqrtf(wave_sum(q) * (1.0f / 1024.0f) + LN_EPS);
#pragma unroll
        for (int j = 0; j < 16; ++j) v[j] = v[j] * rstd * gn[j] + bs[j];
        if (l == DEPTH - 1) { float* orow = ((float*)ldptr(pt, I_OUT)) + (size_t)t * 1024;
            *(f32x4*)(orow + 8 * lane) = (f32x4){v[0], v[1], v[2], v[3]}; *(f32x4*)(orow + 8 * lane + 4) = (f32x4){v[4], v[5], v[6], v[7]};
            *(f32x4*)(orow + 512 + 8 * lane) = (f32x4){v[8], v[9], v[10], v[11]}; *(f32x4*)(orow + 512 + 8 * lane + 4) = (f32x4){v[12], v[13], v[14], v[15]}; }
        else { quant_row(ws, t, v, lane); bf16* xr = XB + (size_t)t * 1024; u32x4 o0, o1; o0.x = pk2(v[0], v[1]); o0.y = pk2(v[2], v[3]); o0.z = pk2(v[4], v[5]); o0.w = pk2(v[6], v[7]);
            o1.x = pk2(v[8], v[9]); o1.y = pk2(v[10], v[11]); o1.z = pk2(v[12], v[13]); o1.w = pk2(v[14], v[15]); *(u32x4*)(xr + 8 * lane) = o0; *(u32x4*)(xr + 512 + 8 * lane) = o1; }
      }
    }
}
constexpr int NPH = 13;
#ifndef PHMASK
#define PHMASK 0x1fff
#endif
#ifndef SUB
#define SUB 7
#endif
#ifndef STAGGER_N
#define STAGGER_N 2
#endif
#ifndef MK_PER_PHASE
#define MK_PER_PHASE 0
#endif
__global__ void __launch_bounds__(512, 2) mk_fwd(Args args, int p_lo, int p_hi, int li) {
    extern __shared__ __attribute__((aligned(16))) uchar lds_raw[];
    LAS uchar* lds = (LAS uchar*)lds_raw;
    const int tid = threadIdx.x;
    const int G = gridDim.x, bx = blockIdx.x;
    const int vcu = (G % 8 == 0) ? (bx % 8) * (G / 8) + bx / 8 : bx;
    for (int u = tid; u < (LDS_BYTES - MISC_OFF) / 4; u += 512) ((LAS unsigned*)(lds + MISC_OFF))[u] = 0u;
    __syncthreads();
    if (tid == 0) { LAS unsigned long long* w = (LAS unsigned long long*)(lds + MISC_OFF + MO_PTAB);
#pragma unroll
        for (int k = 0; k < 29; ++k) w[k] = (unsigned long long)args.in[k];
        w[I_OUT] = (unsigned long long)args.out; w[I_WS] = (unsigned long long)args.ws; }
    __syncthreads();
    XcdBarrier bar = xcd_barrier_post((unsigned*)(args.ws + WS_CTL) + CW_BAR + li * XCD_BAR_WORDS, (volatile LAS unsigned*)(lds + MISC_OFF + MO_BAR));
    PT pt = (PT)(lds + MISC_OFF + MO_PTAB);
#define IN(P) (p_lo <= (P) && (P) < p_hi)
#define PH_BEGIN asm volatile("" ::: "memory"); uchar* ws = (uchar*)ldptr(pt, I_WS); float* ssq = (float*)(ws + WS_SSQ); (void)ssq
#define STAGGER() do { if (bx & 1) { for (int _i = 0; _i < STAGGER_N; ++_i) __builtin_amdgcn_s_sleep(127); } } while (0)
#define SEAM(P) do { if (IN((P) + 1)) xcd_barrier(bar); } while (0)
    for (int l = 0; l < DEPTH; ++l) {
        const int P0 = l * NPH;
        if (((PHMASK >> 0) & 1) && IN(P0 + 0)) { PH_BEGIN; if (l == 0) { prep_phase(pt, 0, lds, vcu, G); moe_colmax_pass(pt, 0, vcu, G);
            { int* rt = (int*)(ws + WS_ROWTOK); for (size_t i = (size_t)vcu * 512 + ltid(); i < (size_t)32 * ECAP; i += (size_t)G * 512) rt[i] = 0; }
            SEAM(P0 + 0); } }
        if (((PHMASK >> 1) & 1) && IN(P0 + 1)) { PH_BEGIN;
            pg8::SplitSched S; S.base.init(T / 256, 10, G, bx, ws + WS_XQ1, (size_t)256 * 1024, ws + W_IN, (size_t)256 * 1024); S.A2 = (const char*)(ws + WS_XQ2); S.split = XQ_SPLIT; S.a_step = (size_t)256 * 1024;
            epi::InProj8 E{{(bf16*)(ws + WS_U1), (bf16*)(ws + WS_UC), (bf16*)(ws + WS_KV), ssq, (const f32x2*)(ws + WS_ROPEA), (const f32x2*)(ws + WS_ROPEB), 0.17677669529663687f * LOG2E}, (const float*)(ws + WS_XRS), (const float*)(ws + WS_ICS)};
            pg8::gemm_phase<epi::InProj8, pg8::SplitSched, false, false, false, true>(lds, 512, 512, S, E);
            SEAM(P0 + 1);
        }
        if (((PHMASK >> 2) & 1) && IN(P0 + 2)) { PH_BEGIN;
            if (SUB & 1) { pg8::GridSched S; S.init(T / 256, 3, G, bx, ws + WS_U1 + 1536 * 2, (size_t)256 * U1_LD * 2, ws + W_UQ, (size_t)256 * 256 * 2);
              epi::QUp E{(bf16*)(ws + WS_Q), ssq, (const f32x2*)(ws + WS_ROPEA), 0.10206207261596577f * LOG2E};
              pg8::gemm_phase<epi::QUp, pg8::GridSched, false>(lds, 256, U1_LD, S, E); }
            if (SUB & 2) { pg8::GridSched S; S.init(T / 256, 4, G, bx, ws + WS_U1 + 1792 * 2, (size_t)256 * U1_LD * 2, ws + W_UKV, (size_t)256 * 128 * 2);
              epi::KVUp E{(bf16*)(ws + WS_KV), ssq};
              pg8::gemm_phase<epi::KVUp, pg8::GridSched, false>(lds, 128, U1_LD, S, E); }
            if (SUB & 4) { pg8::GridSched S; S.init(512, 1, G, bx, ws + WS_UC, (size_t)256 * UC_LD * 2, ws + W_SS, 0, 16, (size_t)256 * 256 * 2);
              epi::SsmS E{(bf16*)(ws + WS_S)};
              pg8::gemm_phase<epi::SsmS, pg8::GridSched, false>(lds, 256, UC_LD, S, E); }
            SEAM(P0 + 2);
        }
        if (((PHMASK >> 3) & 1) && IN(P0 + 3)) { PH_BEGIN; scan_phase(pt, vcu, G); attn_phase(pt, l, lds, bx, G, vcu); SEAM(P0 + 3); }
        if (((PHMASK >> 4) & 1) && IN(P0 + 4)) { PH_BEGIN;
            if (SUB & 1) { pg8::SplitSched S; S.base.init(T / 256, 12, G, bx, ws + WS_XQ1, (size_t)256 * 1024, ws + W_G, (size_t)256 * 1024); S.A2 = (const char*)(ws + WS_XQ2); S.split = XQ_SPLIT; S.a_step = (size_t)256 * 1024;
              epi::Gate8 E{(uchar*)(ws + WS_G), (const float*)ldptr(pt, I_BGATE) + l * 3072, (const float*)(ws + WS_XRS), (const float*)(ws + WS_GCS)};
              pg8::gemm_phase<epi::Gate8, pg8::SplitSched, false, false, false, true>(lds, 512, 512, S, E); }
            if (SUB & 2) { pg8::GridSched S; S.init(512, 1, G, bx, ws + WS_UC, (size_t)256 * UC_LD * 2, ws + W_SY, 0, 16, (size_t)256 * 384 * 2);
              epi::SsmY E{(const bf16*)(ws + WS_UC), (bf16*)(ws + WS_O3), (const float*)ldptr(pt, I_SSMD) + l * 512};
              pg8::gemm_phase<epi::SsmY, pg8::GridSched, false>(lds, 384, UC_LD, S, E); }
            SEAM(P0 + 4);
        }
        if (((PHMASK >> 5) & 1) && IN(P0 + 5)) { PH_BEGIN;
            pg8::TriSched S; S.base.init(T / 256, 4, G, bx, ws + WS_O3, (size_t)256 * O3_LD * 2, ws + W_A, (size_t)256 * 1024 * 2); S.Bglu = (const char*)(ws + W_GLU2);
            epi::GluAB E{{(bf16*)(ws + WS_MG), (const uchar*)(ws + WS_G)}, {(bf16*)(ws + WS_MG), (const uchar*)(ws + WS_G)}};
            pg8::gemm_phase<epi::GluAB, pg8::TriSched, false, true, true>(lds, 1024, O3_LD, S, E);
            SEAM(P0 + 5);
        }
        if (((PHMASK >> 7) & 1) && IN(P0 + 7)) { PH_BEGIN;
            pg8::GridSched S; S.init(T / 256, 4, G, bx, ws + WS_MG, (size_t)256 * 1024 * 2, ws + W_O, (size_t)256 * 1024 * 2);
            epi::OutProj E{(bf16*)(ws + WS_Z), (const bf16*)(ws + WS_XB)};
            pg8::gemm_phase<epi::OutProj, pg8::GridSched, false>(lds, 1024, 1024, S, E);
            SEAM(P0 + 7);
        }
        if (((PHMASK >> 8) & 1) && IN(P0 + 8)) { PH_BEGIN; ln1_router_phase(pt, l, lds, vcu, G); SEAM(P0 + 8); }
        if (((PHMASK >> 10) & 1) && IN(P0 + 10)) { PH_BEGIN;
            moe_tables(pt, l, lds);
            MoeSched S{G, vcu, (const LAS int*)(lds + MISC_OFF + MO_MTS), (const char*)(ws + WS_XQ1), 0, (const char*)(ws + WS_WM1), (size_t)1024 * 1024, (size_t)256 * 1024, (const int*)(ws + WS_ROWTOK), 128};
            epi::Moe1_8 E{(bf16*)(ws + WS_H), (const float*)(ws + WS_XRS), (const float*)(ws + WS_MCM) + (size_t)l * 32 * 1024};
            pg8::gemm_phase<epi::Moe1_8, MoeSched, true, false, false, true>(lds, 512, 512, S, E);
            if (l + 1 < DEPTH) {
                const int nun = __builtin_amdgcn_readfirstlane(((const LAS int*)(lds + MISC_OFF + MO_MTS))[32]) * 4, rem = nun % G;
                __syncthreads();
                if (vcu >= rem) prep_phase(pt, l + 1, lds, vcu - rem, G - rem);
            }
            SEAM(P0 + 10);
        }
        if (((PHMASK >> 11) & 1) && IN(P0 + 11)) { PH_BEGIN;
            moe_tables(pt, l, lds);
            MoeSched S{G, vcu, (const LAS int*)(lds + MISC_OFF + MO_MTS), (const char*)(ws + WS_H), (size_t)256 * 512 * 2, (const char*)(ws + WS_WM2), (size_t)1024 * 512 * 2, (size_t)256 * 512 * 2, (const int*)(ws + WS_ROWTOK), 256};
            epi::Moe2 E{(uchar*)(ws + WS_YB)};
            pg8::gemm_phase<epi::Moe2, MoeSched, false>(lds, 512, 512, S, E);
            SEAM(P0 + 11);
        }
        if (((PHMASK >> 12) & 1) && IN(P0 + 12)) { PH_BEGIN; ln2_phase(pt, l, lds, vcu, G); if (l + 1 < DEPTH) SEAM(P0 + 12); }
    }
#undef IN
#undef SEAM
}

__global__ void dbg_dump(const bf16* src, int ld, int col0, float* out) {
    for (size_t i = (size_t)blockIdx.x * 256 + threadIdx.x; i < (size_t)T * 1024; i += (size_t)gridDim.x * 256) { const size_t t = i >> 10; const int c = (int)(i & 1023); out[i] = __uint_as_float(((unsigned)src[t * ld + col0 + c]) << 16); }
}
extern "C" void kernel_launch(void* const* d_in, const int* in_sizes, int n_in, void* d_out, int out_size, void* d_ws, size_t ws_size, hipStream_t stream) {
    static int grid = 0;
    if (grid == 0) {
        if (n_in != 29 || in_sizes[0] != T * D_MODEL || out_size != T * D_MODEL || ws_size < WS_END) { fprintf(stderr, "kernel_launch: unexpected shapes / workspace (%d inputs, ws %zu < %zu)\n", n_in, ws_size, (size_t)WS_END); grid = -1; return; }
        int dev = 0, cus = 0, per_cu = 0;
        if (hipGetDevice(&dev) != hipSuccess || hipDeviceGetAttribute(&cus, hipDeviceAttributeMultiprocessorCount, dev) != hipSuccess) { grid = -1; return; }
        if (hipFuncSetAttribute((const void*)mk_fwd, hipFuncAttributeMaxDynamicSharedMemorySize, LDS_BYTES) != hipSuccess) { fprintf(stderr, "kernel_launch: hipFuncSetAttribute failed\n"); grid = -1; return; }
        if (hipOccupancyMaxActiveBlocksPerMultiprocessor(&per_cu, (const void*)mk_fwd, 512, LDS_BYTES) != hipSuccess || per_cu < 1) fprintf(stderr, "kernel_launch: occupancy query reports %d\n", per_cu);
        (void)hipGetLastError();
        grid = cus;
    }
    if (grid < 0) return;
    if (hipMemsetAsync((char*)d_ws + WS_CTL, 0, WS_ZERO_BYTES, stream) != hipSuccess) return;
    Args a{};
    for (int i = 0; i < 29; ++i) a.in[i] = d_in[i];
    a.out = (float*)d_out; a.ws = (uchar*)d_ws;
#if defined(DBG_STOP)
    for (int p = 0; p < DBG_STOP; ++p) hipLaunchKernelGGL(mk_fwd, dim3(grid), dim3(512), LDS_BYTES, stream, a, p, p + 1, 0);
    hipLaunchKernelGGL(dbg_dump, dim3(4096), dim3(256), 0, stream, (const bf16*)((const uchar*)d_ws + (DBG_OFF)), (int)(DBG_LD), (int)(DBG_COL), (float*)d_out);
#elif MK_PER_PHASE
    for (int p = 0; p < DEPTH * NPH; ++p) hipLaunchKernelGGL(mk_fwd, dim3(grid), dim3(512), LDS_BYTES, stream, a, p, p + 1, 0);
#else
    hipLaunchKernelGGL(mk_fwd, dim3(grid), dim3(512), LDS_BYTES, stream, a, 0, DEPTH * NPH, 0);
#if defined(PROBE_PH)
    for (int rep = 0; rep < 4; ++rep) for (int k = 0; k < NPH - 1; ++k) if ((PROBE_PH >> k) & 1) hipLaunchKernelGGL(mk_fwd, dim3(grid), dim3(512), LDS_BYTES, stream, a, 3 * NPH + k, 3 * NPH + k + 1, 1);
#endif
#endif
}
```

```cpp
#include <hip/hip_runtime.h>
#include <cstdio>
#include <cstdint>

#define GAS __attribute__((address_space(1)))
#define LAS __attribute__((address_space(3)))
typedef unsigned short bf16;
typedef unsigned char uchar;
typedef short bf16x8 __attribute__((ext_vector_type(8)));
typedef short s16x4 __attribute__((ext_vector_type(4)));
typedef float f32x2 __attribute__((ext_vector_type(2)));
typedef float f32x4 __attribute__((ext_vector_type(4)));
typedef float f32x16 __attribute__((ext_vector_type(16)));
typedef unsigned u32x4 __attribute__((ext_vector_type(4)));
typedef unsigned u32x2 __attribute__((ext_vector_type(2)));

constexpr int D_MODEL = 1024, BATCH = 16, SEQ = 4096, DEPTH = 4, T = BATCH * SEQ;
constexpr int IN_WIDTH = 5536;
constexpr int N_EXP = 32, EXP_FF = 512;
constexpr int NASSIGN = 2 * T;
constexpr int RMAX = NASSIGN + N_EXP * 256;
constexpr float LN_EPS = 1e-5f, RMS_EPS = 1e-6f;
constexpr float DN_ALPHA = 1.6817928305074292f;
constexpr float LOG2E = 1.4426950408889634f;
constexpr int NCHUNK = T / 16;
constexpr int UC_LD = 384;
constexpr int U1_LD = 2048, O3_LD = 1536, G_LD = 3072, KV_LD = 1056;

constexpr size_t MiB = 1u << 20;
constexpr size_t WS_CTL = 0, WS_ZERO_BYTES = 1 * MiB;
constexpr size_t WS_SSQ = 1 * MiB;
constexpr size_t WS_ROPEA = 4 * MiB;
constexpr size_t WS_ROPEB = 12 * MiB;
constexpr size_t WS_TOKE = 14 * MiB;
constexpr size_t WS_TOKW = 14 * MiB + 512 * 1024;
constexpr size_t WS_TOKP = 15 * MiB;
constexpr size_t WS_SLOT = 15 * MiB + 512 * 1024;
constexpr size_t WS_ROWTOK = 986 * MiB;
constexpr int ECAP = 65536;
constexpr size_t WS_A16 = 17 * MiB;
constexpr size_t WS_RWH = 17 * MiB + 64 * 1024, WS_RWL = 17 * MiB + 128 * 1024;
constexpr size_t WS_WTS = 18 * MiB;
constexpr size_t W_IN = WS_WTS;
constexpr size_t W_G = W_IN + 5 * MiB;
constexpr size_t W_UQ = W_G + 6 * MiB;
constexpr size_t W_UKV = W_UQ + 384 * 1024;
constexpr size_t W_A = W_UKV + 512 * 1024;
constexpr size_t W_B = W_A + 1 * MiB;
constexpr size_t W_GLU = W_B + 1 * MiB;
constexpr size_t W_O = W_GLU + 2 * MiB;
constexpr size_t W_SS = W_O + 2 * MiB;
constexpr size_t W_SY = W_SS + 4 * MiB;
static_assert(W_SY + 6 * MiB <= 46 * MiB, "wts");
constexpr size_t WS_XB = 46 * MiB;
constexpr size_t WS_U1 = 174 * MiB;
constexpr size_t WS_Q = 430 * MiB;
constexpr size_t WS_KV = 526 * MiB;
constexpr size_t WS_UC = 658 * MiB;
constexpr size_t WS_O3 = 754 * MiB;
constexpr size_t WS_MG = 366 * MiB;
constexpr size_t WS_END = 1154 * MiB;
constexpr size_t W_GLU2 = 978 * MiB;
constexpr size_t WS_XRS = 982 * MiB;
constexpr size_t WS_GCS = 982 * MiB + 512 * 1024;
constexpr size_t WS_ICS = 982 * MiB + 768 * 1024;
constexpr size_t WS_XQ1 = 994 * MiB, WS_XQ2 = 1106 * MiB;
constexpr int XQ_SPLIT = 64;
constexpr int XQ_VOFF = (int)((WS_XQ2 - WS_XQ1) / 1024) - XQ_SPLIT * 256;
constexpr size_t WS_MCM = 512 * 1024;
constexpr size_t WS_G = WS_U1;
constexpr size_t WS_S = 946 * MiB;
constexpr size_t WS_Z = WS_O3;
constexpr size_t WS_H = WS_U1;
constexpr size_t WS_YB = WS_U1 + 136 * MiB;
constexpr size_t WS_WM1 = 1010 * MiB;
constexpr size_t WS_WM2 = 1074 * MiB;
static_assert((size_t)RMAX * 512 * 2 <= 136 * MiB && WS_YB + (size_t)RMAX * 1024 * 2 <= WS_UC && WS_G + (size_t)T * 3072 <= WS_MG && WS_MG + (size_t)T * 1024 * 2 <= WS_KV && WS_S + (64u << 20) <= WS_WM1, "workspace overlays");
constexpr int CW_BAR = 4096;
constexpr int CW_CNT = 2048;

constexpr int RING_BYTES = 131072;
constexpr int MISC_OFF = RING_BYTES;
constexpr int LDS_BYTES = 147456;
constexpr int MO_BAR = 0, MO_HIST = 64, MO_BASE = 192, MO_MTS = 320, MO_PADS = 512, MO_LAM = 704, MO_RSCR = 1024  , MO_PE = 5120, MO_PR = 7168, MO_PTAB = 9216;

#define LDS_WAIT() asm volatile("s_waitcnt lgkmcnt(0)" ::: "memory")
#define VM_WAIT() asm volatile("s_waitcnt vmcnt(0)" ::: "memory")
__device__ __forceinline__ unsigned f2bf(float f) { unsigned u = __builtin_bit_cast(unsigned, f); return (u + 0x7fffu + ((u >> 16) & 1u)) >> 16; }
__device__ __forceinline__ unsigned pk2(float lo, float hi) { return f2bf(lo) | (f2bf(hi) << 16); }
typedef __bf16 bf16x2_t __attribute__((ext_vector_type(2)));
__device__ __forceinline__ unsigned cvt_pk_bf16(float lo, float hi) { const f32x2 v = {lo, hi}; const bf16x2_t b = __builtin_convertvector(v, bf16x2_t); return __builtin_bit_cast(unsigned, b); }
__device__ __forceinline__ float bflo(unsigned w) { return __uint_as_float(w << 16); }
__device__ __forceinline__ float bfhi(unsigned w) { return __uint_as_float(w & 0xffff0000u); }
__device__ __forceinline__ float fast_sigmoid(float x) { return __builtin_amdgcn_rcpf(1.0f + __builtin_amdgcn_exp2f(-x * LOG2E)); }
__device__ __forceinline__ int ltid() { int t = threadIdx.x; asm volatile("" : "+v"(t)); return t; }
__device__ __forceinline__ float wave_max(float v) {
#pragma unroll
    for (int o = 1; o < 64; o <<= 1) v = fmaxf(v, __shfl_xor(v, o));
    return v;
}
__device__ __forceinline__ unsigned pack4_i8(float a, float b, float c, float d) { unsigned w = 0u;
    w = __builtin_amdgcn_cvt_pk_u8_f32(a + 128.0f, 0, w); w = __builtin_amdgcn_cvt_pk_u8_f32(b + 128.0f, 1, w); w = __builtin_amdgcn_cvt_pk_u8_f32(c + 128.0f, 2, w); w = __builtin_amdgcn_cvt_pk_u8_f32(d + 128.0f, 3, w);
    return w ^ 0x80808080u; }
__device__ __forceinline__ float wave_sum(float v) {
#pragma unroll
    for (int o = 1; o < 64; o <<= 1) v += __shfl_xor(v, o);
    return v;
}

#define XB_TMO      128
#define XB_XCNT(j)  (256  + 64 * (j))
#define XB_XSUB(j)  (1280 + 64 * (j))
#define XB_XGEN(j)  (2304 + 64 * (j))
#define XB_TOP      3328
#define XB_TOPGEN   3392
#define XCD_BAR_WORDS 3456
#define XB_SPIN_CAP (1u << 18)
__device__ __forceinline__ unsigned xb_ld(unsigned* p)              { return __hip_atomic_load(p, __ATOMIC_RELAXED, __HIP_MEMORY_SCOPE_AGENT); }
__device__ __forceinline__ unsigned xb_add(unsigned* p, unsigned v) { return __hip_atomic_fetch_add(p, v, __ATOMIC_RELAXED, __HIP_MEMORY_SCOPE_AGENT); }
__device__ __forceinline__ unsigned xb_xcc_id() { return (unsigned)__builtin_amdgcn_s_getreg((3 << 11) | 20) & 0xFu; }
#define XB_SPIN(cond, bar) do { unsigned _sp = 0; while (cond) { __builtin_amdgcn_s_sleep(1); \
    if ((++_sp & 255u) == 0u) { if (xb_ld(&(bar)[XB_TMO])) break; if (_sp > XB_SPIN_CAP) { atomicAdd(&(bar)[XB_TMO], 1u); break; } } } } while (0)
struct XcdBarrier { unsigned* bar; unsigned x; volatile LAS unsigned* st; };
__device__ __forceinline__ XcdBarrier xcd_barrier_post(unsigned* bar, volatile LAS unsigned* st) {
    XcdBarrier b; b.bar = nullptr; b.x = 0; b.st = st;
    const unsigned x = xb_xcc_id();
    if (threadIdx.x == 0) { (void)xb_add(&bar[XB_XCNT(x)], 1u); st[2] = x; st[4] = (unsigned)(unsigned long long)bar; st[5] = (unsigned)((unsigned long long)bar >> 32); }
    return b;
}
__device__ __forceinline__ void xcd_barrier_complete(unsigned* bar, unsigned x, unsigned& nloc, unsigned& nx) {
    const unsigned G = gridDim.x * gridDim.y * gridDim.z;
    unsigned sum, cnt, mine, sp = 0u;
    for (;;) {
        sum = 0u; cnt = 0u; mine = 0u;
#pragma unroll
        for (unsigned j = 0; j < 16; ++j) { const unsigned c = xb_ld(&bar[XB_XCNT(j)]); sum += c; cnt += (c > 0u) ? 1u : 0u; mine = (j == x) ? c : mine; }
        if (sum == G) break;
        __builtin_amdgcn_s_sleep(1);
        if ((++sp & 255u) == 0u) { if (xb_ld(&bar[XB_TMO])) break; if (sp > XB_SPIN_CAP) { atomicAdd(&bar[XB_TMO], 1u); break; } }
    }
    nloc = mine > 0u ? mine : 1u; nx = cnt > 0u ? cnt : 1u;
}
__device__ __forceinline__ void xcd_barrier(const XcdBarrier& b) {
    asm volatile("s_waitcnt vmcnt(0)" ::: "memory");
    __syncthreads();
    if (threadIdx.x == 0) {
        __builtin_amdgcn_s_waitcnt(0);
        unsigned* bar = (unsigned*)(((unsigned long long)b.st[5] << 32) | (unsigned long long)b.st[4]); const unsigned bx_ = b.st[2];
        unsigned nloc = b.st[0], nx = b.st[1];
        if (nloc == 0u) { xcd_barrier_complete(bar, bx_, nloc, nx); b.st[0] = nloc; b.st[1] = nx; }
        const unsigned old = xb_add(&bar[XB_XSUB(bx_)], 1u);
        const unsigned gen = old / nloc;
        if (old + 1u == (gen + 1u) * nloc) {
            __builtin_amdgcn_fence(__ATOMIC_RELEASE, "agent");
            asm volatile("s_waitcnt vmcnt(0)" ::: "memory");
            const unsigned og = xb_add(&bar[XB_TOP], 1u);
            const unsigned tg = og / nx;
            if (og + 1u == (tg + 1u) * nx) xb_add(&bar[XB_TOPGEN], 1u);
            else XB_SPIN(xb_ld(&bar[XB_TOPGEN]) == tg, bar);
            __builtin_amdgcn_fence(__ATOMIC_ACQUIRE, "agent");
            xb_add(&bar[XB_XGEN(bx_)], 1u);
            asm volatile("s_waitcnt vmcnt(0)" ::: "memory");
        } else {
            XB_SPIN(xb_ld(&bar[XB_XGEN(bx_)]) == gen, bar);
            __builtin_amdgcn_fence(__ATOMIC_ACQUIRE, "agent");
            asm volatile("s_waitcnt vmcnt(0)" ::: "memory");
        }
    }
    __syncthreads();
}

struct Args { const void* in[29]; float* out; uchar* ws; };
typedef const LAS unsigned long long* PT;
__device__ __forceinline__ const void* ldptr(PT pt, int k) { const unsigned long long v = pt[k]; const unsigned lo = __builtin_amdgcn_readfirstlane((unsigned)v), hi = __builtin_amdgcn_readfirstlane((unsigned)(v >> 32)); return (const void*)(const GAS void*)(((unsigned long long)hi << 32) | lo); }
enum { I_X = 0, I_POS, I_WIN, I_BGATE, I_QNORM, I_WUQ, I_KVNORM, I_WUKV, I_WAOUT, I_LAMBDA, I_SUBLN, I_WBOUT, I_ARE, I_AIM, I_LOGDT, I_BRE, I_BIM, I_CRE, I_CIM, I_SSMD, I_WGLU, I_WO, I_LNG, I_LNB, I_RW, I_RB, I_MG, I_MU, I_MD, I_OUT, I_WS };


namespace pg8 {
constexpr int BM = 256, BK = 64, HALF = 128, HTB = HALF * BK * 2, STAGE_BYTES = 8 * HTB, NXCD = 8, WGM = 8;
__host__ __device__ __forceinline__ int lds_byte(int r, int c) { const int st = (r >> 4) * 2 + (c >> 5), rr = r & 15, cc = c & 31, ob = rr * 64 + cc * 2; return st * 1024 + (ob ^ (((ob >> 9) & 1) << 5)); }
__host__ __device__ __forceinline__ void stage_rc(int b, int& R, int& C) { const int st = b / 1024, sb = b % 1024, swz = sb ^ (((sb >> 9) & 1) << 5); R = (st >> 1) * 16 + swz / 64; C = (st & 1) * 32 + (swz % 64) / 2; }
__host__ __device__ __forceinline__ int perm32(int rho) { const int n = rho >> 4, i = rho & 15; return 8 * (i >> 2) + 4 * n + (i & 3); }

struct Unit { const char* A; const char* B; const int* rows; int r0, c0, aux, kt; };

struct GridSched {
    int nM, nN, nwg, G, c, b_div; const char* Ab; const char* Bb; size_t a_step, bn_step, bg_step; int c_step;
    __device__ __forceinline__ void init(int nM_, int nN_, int G_, int c_, const void* A, size_t a_step_, const void* B, size_t bn_step_, int b_div_ = 1 << 30, size_t bg_step_ = 0, int c_step_ = 256) {
        nM = nM_; nN = nN_; nwg = nM * nN; G = G_; c = c_; Ab = (const char*)A; a_step = a_step_; Bb = (const char*)B; bn_step = bn_step_; b_div = b_div_; bg_step = bg_step_; c_step = c_step_; }
    __device__ __forceinline__ bool next(int i, Unit& u) const {
        const long L = (long)i * G + c; if (L >= nwg) return false;
        int wgid = (int)L; { const int q = nwg / NXCD, r = nwg % NXCD, xcd = wgid % NXCD, off = wgid / NXCD; wgid = (xcd < r ? xcd * (q + 1) : r * (q + 1) + (xcd - r) * q) + off; }
        const int nig = WGM * nN, gid = wgid / nig, fm = gid * WGM, gsz = (nM - fm) < WGM ? (nM - fm) : WGM;
        const int pm = fm + ((wgid % nig) % gsz), pn = (wgid % nig) / gsz;
        u.A = Ab + (size_t)pm * a_step; u.B = Bb + (size_t)pn * bn_step + (size_t)(pm / b_div) * bg_step; u.rows = nullptr; u.r0 = pm * BM; u.c0 = pn * c_step; u.aux = pn; return true;
    }
};

struct PairSched { GridSched base; long a_off, b_off;
    __device__ __forceinline__ bool next(int j, Unit& u) const { if (!base.next(j >> 1, u)) return false; if (j & 1) { u.A += a_off; u.B += b_off; } u.aux = j & 1; return true; } };

typedef int i32x4 __attribute__((ext_vector_type(4)));
template <bool I8> __device__ __forceinline__ f32x4 mma_sel(const bf16x8& b, const bf16x8& a, const f32x4& c) {
    if constexpr (I8) return __builtin_bit_cast(f32x4, __builtin_amdgcn_mfma_i32_16x16x64_i8(__builtin_bit_cast(i32x4, b), __builtin_bit_cast(i32x4, a), __builtin_bit_cast(i32x4, c), 0, 0, 0));
    else return __builtin_amdgcn_mfma_f32_16x16x32_bf16(b, a, c, 0, 0, 0);
}
struct SplitSched { GridSched base; const char* A2; int split; size_t a_step;
    __device__ __forceinline__ bool next(int i, Unit& u) const { if (!base.next(i, u)) return false; const int pm = u.r0 >> 8; if (pm >= split) u.A = A2 + (size_t)(pm - split) * a_step; return true; } };
struct TriSched { GridSched base; const char* Bglu;
    __device__ __forceinline__ bool next(int j, Unit& u) const { const int tile = j / 3, k = j - 3 * tile; if (!base.next(tile, u)) return false; const int pn = u.aux;
        if (k < 2) { u.A += 1024 * 2; u.B = Bglu + (size_t)(2 * pn + k) * (256 * 1024 * 2); u.c0 = (2 * pn + k) * 128; u.kt = 8; } else u.kt = 16;
        u.aux = k; return true; } };

#define PG8_SA(b, h) (((b) * 2 + (h)) * HTB)
#define PG8_SB(b, h) ((4 + (b) * 2 + (h)) * HTB)
#define PG8_STAGE_B(bufoff, gbase) do { const char* _g = (const char*)(gbase); asm volatile("" : "+s"(_g)); _Pragma("unroll") for (int _i = 0; _i < 2; ++_i) \
        __builtin_amdgcn_global_load_lds((const unsigned*)(_g + voffB[_i]), (LAS unsigned*)(lds + (bufoff) + ldsw + _i * 8192), 16, 0, 0); } while (0)
#define PG8_STAGE_A(bufoff, gbase, vo, h) do { const char* _g = (const char*)(gbase); asm volatile("" : "+s"(_g)); _Pragma("unroll") for (int _i = 0; _i < 2; ++_i) \
        __builtin_amdgcn_global_load_lds((const unsigned*)(_g + (vo)[h][_i]), (LAS unsigned*)(lds + (bufoff) + ldsw + _i * 8192), 16, 0, 0); } while (0)
#define PG8_LDA(dst, b, h) do { _Pragma("unroll") for (int m = 0; m < 4; ++m) _Pragma("unroll") for (int k = 0; k < 2; ++k) dst[m][k] = *(const LAS bf16x8*)(lds + PG8_SA(b, h) + aoff + m * 2048 + k * 1024); } while (0)
#define PG8_LDB(dst, b, h) do { _Pragma("unroll") for (int n = 0; n < 2; ++n) _Pragma("unroll") for (int k = 0; k < 2; ++k) dst[n][k] = *(const LAS bf16x8*)(lds + PG8_SB(b, h) + boff + n * 2048 + k * 1024); } while (0)
#define PG8_MMA(ai, bj, At, Bt) do { __builtin_amdgcn_s_setprio(1); _Pragma("unroll") for (int m = 0; m < 4; ++m) _Pragma("unroll") for (int n = 0; n < 2; ++n) _Pragma("unroll") for (int k = 0; k < 2; ++k) \
        acc[ai][bj][m][n] = mma_sel<I8>(Bt[n][k], At[m][k], acc[ai][bj][m][n]); __builtin_amdgcn_s_setprio(0); } while (0)
#define PG8_WAIT_V(n) asm volatile("s_waitcnt vmcnt(" #n ")" ::: "memory")
#define PG8_WAIT_L(n) asm volatile("s_waitcnt lgkmcnt(" #n ")" ::: "memory")
#define PG8_BAR __builtin_amdgcn_s_barrier()
#define PG8_SCHED __builtin_amdgcn_sched_barrier(0)

template <class Epi, class Sched, bool GATHER, bool HOOK = false, bool VARK = false, bool I8 = false>
__device__ __forceinline__ void gemm_phase(LAS uchar* lds, const int K, const int lda, const Sched& S, const Epi& E) {
    const int tid = ltid(), wid = __builtin_amdgcn_readfirstlane(tid >> 6), lane = tid & 63, wr = wid >> 2, wc = wid & 3, fr = lane & 15, fq = lane >> 4;
    int sR[2], sC[2];
    unsigned voffB[2], voA[2][2], nvoA[2][2];
#pragma unroll
    for (int i = 0; i < 2; ++i) { stage_rc(tid * 16 + i * 8192, sR[i], sC[i]); const int Rb = (sR[i] & ~31) + perm32(sR[i] & 31);
        voffB[i] = (unsigned)(Rb * K + sC[i]) * 2u;
#pragma unroll
        for (int h = 0; h < 2; ++h) { voA[h][i] = (unsigned)((h * HALF + sR[i]) * lda + sC[i]) * 2u; nvoA[h][i] = voA[h][i]; } }
    const size_t kstep = (size_t)(BK * 2);
    const size_t hstepB = (size_t)HALF * K * 2;
    const unsigned ldsw = (unsigned)wid * 1024u;
    const int aoff = lds_byte(wr * 64 + fr, fq * 8), boff = lds_byte(wc * 32 + fr, fq * 8);
    Unit cur, nxt; int ui = 0;
    if (!S.next(0, cur)) return;
    if constexpr (GATHER) {
#pragma unroll
        for (int i = 0; i < 2; ++i)
#pragma unroll
            for (int h = 0; h < 2; ++h) voA[h][i] = (unsigned)(cur.rows[h * HALF + sR[i]] * lda + sC[i]) * 2u;
    }
    f32x4 acc[2][2][4][2];
#pragma unroll
    for (int a = 0; a < 2; ++a)
#pragma unroll
        for (int b = 0; b < 2; ++b)
#pragma unroll
            for (int m = 0; m < 4; ++m)
#pragma unroll
                for (int n = 0; n < 2; ++n) acc[a][b][m][n] = (f32x4){0.f, 0.f, 0.f, 0.f};
    bf16x8 At[4][2], B0[2][2], B1[2][2];
    const char* cA = cur.A; const char* cB = cur.B;
    PG8_STAGE_B(PG8_SB(0, 0), cB); PG8_STAGE_B(PG8_SB(0, 1), cB + hstepB); PG8_STAGE_A(PG8_SA(0, 0), cA, voA, 0); PG8_STAGE_A(PG8_SA(0, 1), cA, voA, 1);
    if (wr == 1) PG8_BAR;
    PG8_WAIT_V(2); PG8_BAR;
    PG8_STAGE_B(PG8_SB(1, 0), cB + kstep); PG8_STAGE_A(PG8_SA(1, 0), cA + kstep, voA, 0); PG8_STAGE_B(PG8_SB(1, 1), cB + hstepB + kstep);
    PG8_WAIT_V(6); PG8_BAR;
    for (;;) {
        const int nt = VARK ? cur.kt : K / BK;
        const bool has_next = S.next(ui + 1, nxt);
        const char* nA = has_next ? nxt.A : cA; const char* nB = has_next ? nxt.B : cB;
        if constexpr (GATHER) {
            if (has_next) {
#pragma unroll
                for (int i = 0; i < 2; ++i)
#pragma unroll
                    for (int h = 0; h < 2; ++h) nvoA[h][i] = (unsigned)(nxt.rows[h * HALF + sR[i]] * lda + sC[i]) * 2u;
            } else {
#pragma unroll
                for (int i = 0; i < 2; ++i)
#pragma unroll
                    for (int h = 0; h < 2; ++h) nvoA[h][i] = voA[h][i];
            }
        }
#pragma unroll 1
        for (int t = 0; t < nt; t += 2) {
            if constexpr (HOOK) { if ((!VARK || cur.aux == 2) && t == (nt >> 1)) { int z = 0; asm volatile("" : "+v"(z)); E.scale(acc, cur, wr, wc, fr + z, fq); } }
            const bool last = (t == nt - 2);
            const char* a1 = cA + (size_t)(t + 1) * kstep;
            const char* a2 = last ? nA : cA + (size_t)(t + 2) * kstep; const char* b2 = last ? nB : cB + (size_t)(t + 2) * kstep;
            const char* a3 = a2 + kstep; const char* b3 = b2 + kstep;
            unsigned vo2[2][2];
#pragma unroll
            for (int i = 0; i < 2; ++i)
#pragma unroll
                for (int h = 0; h < 2; ++h) vo2[h][i] = (GATHER && last) ? nvoA[h][i] : voA[h][i];
            PG8_LDB(B0, 0, 0); PG8_LDB(B1, 0, 1); PG8_SCHED; PG8_LDA(At, 0, 0); PG8_STAGE_A(PG8_SA(1, 1), a1, voA, 1);
            PG8_WAIT_V(8); PG8_WAIT_L(0); PG8_BAR; PG8_MMA(0, 0, At, B0); PG8_MMA(0, 1, At, B1); PG8_BAR; PG8_SCHED;
            PG8_LDA(At, 0, 1); PG8_STAGE_B(PG8_SB(0, 0), b2); PG8_STAGE_B(PG8_SB(0, 1), b2 + hstepB); PG8_STAGE_A(PG8_SA(0, 0), a2, vo2, 0);
            PG8_WAIT_V(8); PG8_WAIT_L(0); PG8_BAR; PG8_MMA(1, 0, At, B0); PG8_MMA(1, 1, At, B1); PG8_BAR; PG8_SCHED;
            PG8_LDB(B0, 1, 0); PG8_LDB(B1, 1, 1); PG8_SCHED; PG8_LDA(At, 1, 0); PG8_STAGE_A(PG8_SA(0, 1), a2, vo2, 1);
            PG8_WAIT_V(8); PG8_WAIT_L(0); PG8_BAR; PG8_MMA(0, 0, At, B0); PG8_MMA(0, 1, At, B1); PG8_BAR; PG8_SCHED;
            PG8_LDA(At, 1, 1); PG8_STAGE_B(PG8_SB(1, 0), b3); PG8_STAGE_B(PG8_SB(1, 1), b3 + hstepB); PG8_STAGE_A(PG8_SA(1, 0), a3, vo2, 0);
            PG8_WAIT_V(8); PG8_WAIT_L(0); PG8_BAR; PG8_MMA(1, 0, At, B0); PG8_MMA(1, 1, At, B1); PG8_BAR; PG8_SCHED;
        }
        if (wr == 0) PG8_BAR;
        E(acc, cur, wr, wc, fr, fq);
        if (!has_next) break;
#pragma unroll
        for (int a = 0; a < 2; ++a)
#pragma unroll
            for (int b = 0; b < 2; ++b)
#pragma unroll
                for (int m = 0; m < 4; ++m)
#pragma unroll
                    for (int n = 0; n < 2; ++n) acc[a][b][m][n] = (f32x4){0.f, 0.f, 0.f, 0.f};
        cur = nxt; cA = nA; cB = nB; ++ui;
        if constexpr (GATHER) {
#pragma unroll
            for (int i = 0; i < 2; ++i)
#pragma unroll
                for (int h = 0; h < 2; ++h) voA[h][i] = nvoA[h][i];
        }
        if (wr == 1) PG8_BAR;
    }
    PG8_WAIT_V(0);
    PG8_BAR;
}
}
namespace epi {
using pg8::Unit;
#define EPI_ROWS(ai, m) (u.r0 + (ai) * 128 + wr * 64 + (m) * 16 + fr)
#define EPI_FENCE asm volatile("" ::: "memory")
#define EPI_FOR_AI_M _Pragma("unroll") for (int ai = 0; ai < 2; ++ai) _Pragma("unroll") for (int m = 0; m < 4; ++m)
__device__ __forceinline__ u32x4 pack8(const f32x4& a, const f32x4& b) { u32x4 w; w.x = cvt_pk_bf16(a[0], a[1]); w.y = cvt_pk_bf16(a[2], a[3]); w.z = cvt_pk_bf16(b[0], b[1]); w.w = cvt_pk_bf16(b[2], b[3]); return w; }
__device__ __forceinline__ void unpack8(const u32x4& w, f32x4& a, f32x4& b) { a = (f32x4){bflo(w.x), bfhi(w.x), bflo(w.y), bfhi(w.y)}; b = (f32x4){bflo(w.z), bfhi(w.z), bflo(w.w), bfhi(w.w)}; }

__device__ __forceinline__ u32x2 pack8u(const f32x4& a, const f32x4& b) { u32x2 w; w.x = 0u; w.y = 0u;
    w.x = __builtin_amdgcn_cvt_pk_u8_f32(a[0] * 255.0f, 0, w.x); w.x = __builtin_amdgcn_cvt_pk_u8_f32(a[1] * 255.0f, 1, w.x); w.x = __builtin_amdgcn_cvt_pk_u8_f32(a[2] * 255.0f, 2, w.x); w.x = __builtin_amdgcn_cvt_pk_u8_f32(a[3] * 255.0f, 3, w.x);
    w.y = __builtin_amdgcn_cvt_pk_u8_f32(b[0] * 255.0f, 0, w.y); w.y = __builtin_amdgcn_cvt_pk_u8_f32(b[1] * 255.0f, 1, w.y); w.y = __builtin_amdgcn_cvt_pk_u8_f32(b[2] * 255.0f, 2, w.y); w.y = __builtin_amdgcn_cvt_pk_u8_f32(b[3] * 255.0f, 3, w.y); return w; }
__device__ __forceinline__ void unpack8u(const u32x2& w, f32x4& a, f32x4& b) {
    a = (f32x4){(float)(w.x & 0xffu), (float)((w.x >> 8) & 0xffu), (float)((w.x >> 16) & 0xffu), (float)(w.x >> 24)};
    b = (f32x4){(float)(w.y & 0xffu), (float)((w.y >> 8) & 0xffu), (float)((w.y >> 16) & 0xffu), (float)(w.y >> 24)}; }
__device__ __forceinline__ void rot_pairs(f32x4& a, f32x4& b, const f32x4& cs0, const f32x4& cs1) {
    { const float x1 = a[0], x2 = a[1]; a[0] = x1 * cs0[0] - x2 * cs0[1]; a[1] = x2 * cs0[0] + x1 * cs0[1]; }
    { const float x1 = a[2], x2 = a[3]; a[2] = x1 * cs0[2] - x2 * cs0[3]; a[3] = x2 * cs0[2] + x1 * cs0[3]; }
    { const float x1 = b[0], x2 = b[1]; b[0] = x1 * cs1[0] - x2 * cs1[1]; b[1] = x2 * cs1[0] + x1 * cs1[1]; }
    { const float x1 = b[2], x2 = b[3]; b[2] = x1 * cs1[2] - x2 * cs1[3]; b[3] = x2 * cs1[2] + x1 * cs1[3]; }
}
struct InProj {
    bf16* U1; bf16* UC; bf16* KV; float* ssq; const f32x2* ropeA; const f32x2* ropeB; float qscale;
    __device__ __forceinline__ void operator()(f32x4 (&acc)[2][2][4][2], const Unit& u, int wr, int wc, int fr, int fq) const {
        const int pn = u.aux;
        if (pn >= 8) {
            EPI_FOR_AI_M { const int t = EPI_ROWS(ai, m);
#pragma unroll
                for (int bj = 0; bj < 2; ++bj) { const int ch = (pn - 8) * 256 + bj * 128 + wc * 32 + fq * 8; const int g = ch >> 4, q0 = ch & 15;
                    *(u32x4*)(UC + ((size_t)g * NCHUNK + (t >> 4)) * UC_LD + (t & 15) * 16 + q0) = pack8(acc[ai][bj][m][0], acc[ai][bj][m][1]); } }
            return;
        }
        const float sc = (pn < 2) ? qscale : 1.0f;
        EPI_FOR_AI_M { const int t = EPI_ROWS(ai, m);
            f32x4 v[2][2];
#pragma unroll
            for (int bj = 0; bj < 2; ++bj) { v[bj][0] = acc[ai][bj][m][0]; v[bj][1] = acc[ai][bj][m][1]; }
            if (pn < 4) {
                if (fq == 0) { const f32x4 cs0 = *(const f32x4*)(ropeB + (size_t)t * 4), cs1 = *(const f32x4*)(ropeB + (size_t)t * 4 + 2);
                    const float c[4] = {cs0[0], cs0[2], cs1[0], cs1[2]}, s[4] = {cs0[1], cs0[3], cs1[1], cs1[3]};
#pragma unroll
                    for (int bj = 0; bj < 2; ++bj)
#pragma unroll
                        for (int j = 0; j < 4; ++j) { const float x1 = v[bj][0][j], x2 = v[bj][1][j]; v[bj][0][j] = x1 * c[j] - x2 * s[j]; v[bj][1][j] = x2 * c[j] + x1 * s[j]; } }
#pragma unroll
                for (int bj = 0; bj < 2; ++bj) { v[bj][0] *= sc; v[bj][1] *= sc; }
            } else if (pn == 6) {
                float s = 0.f;
#pragma unroll
                for (int bj = 0; bj < 2; ++bj)
#pragma unroll
                    for (int n = 0; n < 2; ++n) { const f32x4 x = v[bj][n]; s += (x[0] * x[0] + x[1] * x[1]) + (x[2] * x[2] + x[3] * x[3]); }
                s += __shfl_xor(s, 16); s += __shfl_xor(s, 32);
                if (fq == 0) ssq[(size_t)t * 8 + wc] = s;
            } else if (pn == 7) {
                float s = 0.f;
#pragma unroll
                for (int n = 0; n < 2; ++n) { const f32x4 x = v[0][n]; s += (x[0] * x[0] + x[1] * x[1]) + (x[2] * x[2] + x[3] * x[3]); }
                s += __shfl_xor(s, 16); s += __shfl_xor(s, 32);
                if (fq == 0) ssq[(size_t)t * 8 + 4 + wc] = s;
                if (wc == 0) { const f32x4 cs0 = *(const f32x4*)(ropeA + (size_t)t * 16 + 4 * fq), cs1 = *(const f32x4*)(ropeA + (size_t)t * 16 + 4 * fq + 2); rot_pairs(v[1][0], v[1][1], cs0, cs1);
                    *(u32x4*)(KV + (size_t)t * KV_LD + 1024 + fq * 8) = pack8(v[1][0], v[1][1]); }
            }
            bf16* rowp = U1 + (size_t)t * U1_LD + pn * 256 + wc * 32 + fq * 8;
#pragma unroll
            for (int bj = 0; bj < 2; ++bj) if (!(pn == 7 && bj == 1)) *(u32x4*)(rowp + bj * 128) = pack8(v[bj][0], v[bj][1]);
            EPI_FENCE; }
    }
};
struct InProj8 { InProj base; const float* rs; const float* cs;
    __device__ __forceinline__ void operator()(f32x4 (&acc)[2][2][4][2], const Unit& u, int wr, int wc, int fr, int fq) const {
        float rv[8];
#pragma unroll
        for (int g = 0; g < 8; ++g) rv[g] = rs[EPI_ROWS(g >> 2, g & 3)];
        EPI_FOR_AI_M { const float r = rv[ai * 4 + m];
#pragma unroll
            for (int bj = 0; bj < 2; ++bj) { const float* cp = cs + u.c0 + bj * 128 + wc * 32 + fq * 8; asm volatile("" : "+v"(cp));
                const f32x4 c0 = *(const f32x4*)cp * r, c1 = *(const f32x4*)(cp + 4) * r;
#pragma unroll
                for (int j = 0; j < 4; ++j) { acc[ai][bj][m][0][j] = (float)__float_as_int(acc[ai][bj][m][0][j]) * c0[j]; acc[ai][bj][m][1][j] = (float)__float_as_int(acc[ai][bj][m][1][j]) * c1[j]; } }
            EPI_FENCE; }
        base(acc, u, wr, wc, fr, fq);
    }
};

struct QUp {
    bf16* Q; const float* ssq; const f32x2* ropeA; float qscale;
    __device__ __forceinline__ void operator()(f32x4 (&acc)[2][2][4][2], const Unit& u, int wr, int wc, int fr, int fq) const {
        EPI_FOR_AI_M { const int t = EPI_ROWS(ai, m); const f32x4 sp = *(const f32x4*)(ssq + (size_t)t * 8); const float rs = rsqrtf(((sp[0] + sp[1]) + (sp[2] + sp[3])) * (1.0f / 256.0f) + RMS_EPS) * qscale;
#pragma unroll
            for (int bj = 0; bj < 2; ++bj) { f32x4 a = acc[ai][bj][m][0] * rs, b = acc[ai][bj][m][1] * rs;
                const int gi = u.aux * 8 + bj * 4 + wc;
                if (gi % 3 == 2) { const f32x4 cs0 = *(const f32x4*)(ropeA + (size_t)t * 16 + 4 * fq), cs1 = *(const f32x4*)(ropeA + (size_t)t * 16 + 4 * fq + 2); rot_pairs(a, b, cs0, cs1); }
                *(u32x4*)(Q + (size_t)t * 768 + u.c0 + bj * 128 + wc * 32 + fq * 8) = pack8(a, b); }
            EPI_FENCE; }
    }
};
struct KVUp {
    bf16* KV; const float* ssq;
    __device__ __forceinline__ void operator()(f32x4 (&acc)[2][2][4][2], const Unit& u, int wr, int wc, int fr, int fq) const {
        EPI_FOR_AI_M { const int t = EPI_ROWS(ai, m); const f32x4 sp = *(const f32x4*)(ssq + (size_t)t * 8 + 4); const float rs = rsqrtf(((sp[0] + sp[1]) + (sp[2] + sp[3])) * (1.0f / 128.0f) + RMS_EPS);
#pragma unroll
            for (int bj = 0; bj < 2; ++bj) *(u32x4*)(KV + (size_t)t * KV_LD + u.c0 + bj * 128 + wc * 32 + fq * 8) = pack8(acc[ai][bj][m][0] * rs, acc[ai][bj][m][1] * rs);
            EPI_FENCE; }
    }
};
struct SsmS {
    bf16* S;
    __device__ __forceinline__ void operator()(f32x4 (&acc)[2][2][4][2], const Unit& u, int wr, int wc, int fr, int fq) const {
        EPI_FOR_AI_M { bf16* p = S + (size_t)EPI_ROWS(ai, m) * 128 + wc * 32 + fq * 8; *(u32x4*)p = pack8(acc[ai][0][m][0], acc[ai][0][m][1]); }
    }
};
struct SsmY {
    const bf16* UC; bf16* O3; const float* dvec;
    __device__ __forceinline__ void operator()(f32x4 (&acc)[2][2][4][2], const Unit& u, int wr, int wc, int fr, int fq) const {
        EPI_FOR_AI_M { const int rr = EPI_ROWS(ai, m); const int g = rr >> 12, ch = rr & 4095;
#pragma unroll
            for (int bj = 0; bj < 2; ++bj) { const int col = bj * 128 + wc * 32 + fq * 8, i = col >> 4, p0 = col & 15; const int t = ch * 16 + i;
                const u32x4 uw = *(const u32x4*)(UC + (size_t)rr * UC_LD + col); f32x4 ua, ub; unpack8(uw, ua, ub);
                const f32x4 da = *(const f32x4*)(dvec + g * 16 + p0), db = *(const f32x4*)(dvec + g * 16 + p0 + 4);
                f32x4 ya = acc[ai][bj][m][0] + da * ua, yb = acc[ai][bj][m][1] + db * ub;
#pragma unroll
                for (int j = 0; j < 4; ++j) { { const float y = ya[j]; ya[j] = y * fast_sigmoid(1.5957691216057308f * (y + 0.044715f * y * y * y)); }
                                              { const float y = yb[j]; yb[j] = y * fast_sigmoid(1.5957691216057308f * (y + 0.044715f * y * y * y)); } }
                *(u32x4*)(O3 + (size_t)t * O3_LD + 1024 + g * 16 + p0) = pack8(ya, yb); }
            EPI_FENCE; }
    }
};
struct Gate {
    uchar* G; const float* bias;
    __device__ __forceinline__ void operator()(f32x4 (&acc)[2][2][4][2], const Unit& u, int wr, int wc, int fr, int fq) const {
        EPI_FOR_AI_M { uchar* rowp = G + (size_t)EPI_ROWS(ai, m) * G_LD + u.c0 + wc * 32 + fq * 8;
#pragma unroll
            for (int bj = 0; bj < 2; ++bj) { const float* bp = bias + u.c0 + bj * 128 + wc * 32 + fq * 8;
                f32x4 a = acc[ai][bj][m][0] + *(const f32x4*)bp, b = acc[ai][bj][m][1] + *(const f32x4*)(bp + 4);
#pragma unroll
                for (int j = 0; j < 4; ++j) { a[j] = fast_sigmoid(a[j]); b[j] = fast_sigmoid(b[j]); }
                *(u32x2*)(rowp + bj * 128) = pack8u(a, b); }
            EPI_FENCE; }
    }
};
struct Gate8 {
    uchar* G; const float* bias; const float* rs; const float* cs;
    __device__ __forceinline__ void operator()(f32x4 (&acc)[2][2][4][2], const Unit& u, int wr, int wc, int fr, int fq) const {
        float rv[8];
#pragma unroll
        for (int g = 0; g < 8; ++g) rv[g] = rs[EPI_ROWS(g >> 2, g & 3)];
        EPI_FOR_AI_M { const int t = EPI_ROWS(ai, m); const float r = rv[ai * 4 + m]; uchar* rowp = G + (size_t)t * G_LD + u.c0 + wc * 32 + fq * 8;
#pragma unroll
            for (int bj = 0; bj < 2; ++bj) { const int col = u.c0 + bj * 128 + wc * 32 + fq * 8; const float* bp = bias + col; const float* cp = cs + col;
                const f32x4 c0 = *(const f32x4*)cp * r, c1 = *(const f32x4*)(cp + 4) * r; f32x4 a = *(const f32x4*)bp, b = *(const f32x4*)(bp + 4);
#pragma unroll
                for (int j = 0; j < 4; ++j) { a[j] = fast_sigmoid((float)__float_as_int(acc[ai][bj][m][0][j]) * c0[j] + a[j]); b[j] = fast_sigmoid((float)__float_as_int(acc[ai][bj][m][1][j]) * c1[j] + b[j]); }
                *(u32x2*)(rowp + bj * 128) = pack8u(a, b); }
            EPI_FENCE; }
    }
};
struct Glu {
    bf16* MG; const uchar* G;
    __device__ __forceinline__ void operator()(f32x4 (&acc)[2][2][4][2], const Unit& u, int wr, int wc, int fr, int fq) const {
        constexpr int D = 4; u32x2 L[8];
        const int col = u.c0 + wc * 32 + fq * 8;
        const uchar* gp = G + (size_t)(u.r0 + wr * 64 + fr) * G_LD + 2048 + col;
#pragma unroll
        for (int g = 0; g < D; ++g) L[g] = *(const u32x2*)(gp + (size_t)((g >> 2) * 128 + (g & 3) * 16) * G_LD);
#pragma unroll
        for (int g = 0; g < 8; ++g) { const int ai = g >> 2, m = g & 3;
            if (g + D < 8) L[g + D] = *(const u32x2*)(gp + (size_t)(((g + D) >> 2) * 128 + ((g + D) & 3) * 16) * G_LD);
            EPI_FENCE;
            const int t = EPI_ROWS(ai, m); f32x4 ga, gb; unpack8u(L[g], ga, gb);
            f32x4 a = acc[ai][0][m][0], b = acc[ai][0][m][1]; const f32x4 sa = acc[ai][1][m][0], sb = acc[ai][1][m][1];
#pragma unroll
            for (int j = 0; j < 4; ++j) { a[j] = (ga[j] * (1.0f / 255.0f)) * a[j] * fast_sigmoid(sa[j]); b[j] = (gb[j] * (1.0f / 255.0f)) * b[j] * fast_sigmoid(sb[j]); }
            *(u32x4*)(MG + (size_t)t * 1024 + col) = pack8(a, b); }
    }
};
struct Branch {
    bf16* MG; const uchar* G; int goff;
    __device__ __forceinline__ void operator()(f32x4 (&acc)[2][2][4][2], const Unit& u, int wr, int wc, int fr, int fq) const {
        constexpr int D = 3; u32x2 LG[8][2]; u32x4 LM[8][2];
        const int col = u.c0 + wc * 32 + fq * 8; const size_t row = (size_t)(u.r0 + wr * 64 + fr);
        const uchar* gp = G + row * G_LD + goff + u.aux * 1024 + col; bf16* mp = MG + row * 1024 + col;
#define BR_LOAD(g) do { const size_t ro = (size_t)(((g) >> 2) * 128 + ((g) & 3) * 16); _Pragma("unroll") for (int bj = 0; bj < 2; ++bj) { LG[g][bj] = *(const u32x2*)(gp + ro * G_LD + bj * 128); LM[g][bj] = *(const u32x4*)(mp + ro * 1024 + bj * 128); } } while (0)
#pragma unroll
        for (int g = 0; g < D; ++g) BR_LOAD(g);
#pragma unroll
        for (int g = 0; g < 8; ++g) { const int ai = g >> 2, m = g & 3;
            if (g + D < 8) BR_LOAD(g + D);
            EPI_FENCE;
            const size_t ro = (size_t)(ai * 128 + m * 16);
#pragma unroll
            for (int bj = 0; bj < 2; ++bj) { f32x4 ga, gb, ma, mb; unpack8u(LG[g][bj], ga, gb); unpack8(LM[g][bj], ma, mb);
                *(u32x4*)(mp + ro * 1024 + bj * 128) = pack8(ma + (ga * (1.0f / 255.0f)) * acc[ai][bj][m][0], mb + (gb * (1.0f / 255.0f)) * acc[ai][bj][m][1]); } }
#undef BR_LOAD
    }
};
struct BranchAB {
    bf16* MG; const uchar* G;
    __device__ __forceinline__ void scale(f32x4 (&acc)[2][2][4][2], const Unit& u, int wr, int wc, int fr, int fq) const {
        constexpr int D = 3; u32x2 LA[8][2], LB[8][2];
        const int col = u.c0 + wc * 32 + fq * 8; const size_t row = (size_t)(u.r0 + wr * 64 + fr);
        const uchar* gp = G + row * G_LD + col;
#define BS_LOAD(g) do { const size_t ro = (size_t)(((g) >> 2) * 128 + ((g) & 3) * 16); _Pragma("unroll") for (int bj = 0; bj < 2; ++bj) { LA[g][bj] = *(const u32x2*)(gp + ro * G_LD + bj * 128); LB[g][bj] = *(const u32x2*)(gp + ro * G_LD + 1024 + bj * 128); } } while (0)
#pragma unroll
        for (int g = 0; g < D; ++g) BS_LOAD(g);
#pragma unroll
        for (int g = 0; g < 8; ++g) { const int ai = g >> 2, m = g & 3;
            if (g + D < 8) BS_LOAD(g + D);
            EPI_FENCE;
#pragma unroll
            for (int bj = 0; bj < 2; ++bj) { f32x4 a0, a1, b0, b1; unpack8u(LA[g][bj], a0, a1); unpack8u(LB[g][bj], b0, b1);
#pragma unroll
                for (int j = 0; j < 4; ++j) { acc[ai][bj][m][0][j] *= a0[j] * __builtin_amdgcn_rcpf(fmaxf(b0[j], 1.0f)); acc[ai][bj][m][1][j] *= a1[j] * __builtin_amdgcn_rcpf(fmaxf(b1[j], 1.0f)); } } }
#undef BS_LOAD
    }
    __device__ __forceinline__ void operator()(f32x4 (&acc)[2][2][4][2], const Unit& u, int wr, int wc, int fr, int fq) const {
        constexpr int D = 3; u32x2 LG[8][2]; u32x4 LM[8][2];
        const int col = u.c0 + wc * 32 + fq * 8; const size_t row = (size_t)(u.r0 + wr * 64 + fr);
        const uchar* gp = G + row * G_LD + 1024 + col; bf16* mp = MG + row * 1024 + col;
#define BR_LOAD(g) do { const size_t ro = (size_t)(((g) >> 2) * 128 + ((g) & 3) * 16); _Pragma("unroll") for (int bj = 0; bj < 2; ++bj) { LG[g][bj] = *(const u32x2*)(gp + ro * G_LD + bj * 128); LM[g][bj] = *(const u32x4*)(mp + ro * 1024 + bj * 128); } } while (0)
#pragma unroll
        for (int g = 0; g < D; ++g) BR_LOAD(g);
#pragma unroll
        for (int g = 0; g < 8; ++g) { const int ai = g >> 2, m = g & 3;
            if (g + D < 8) BR_LOAD(g + D);
            EPI_FENCE;
            const size_t ro = (size_t)(ai * 128 + m * 16);
#pragma unroll
            for (int bj = 0; bj < 2; ++bj) { f32x4 ga, gb, ma, mb; unpack8u(LG[g][bj], ga, gb); unpack8(LM[g][bj], ma, mb);
#pragma unroll
                for (int j = 0; j < 4; ++j) { ga[j] = fmaxf(ga[j], 1.0f) * (1.0f / 255.0f); gb[j] = fmaxf(gb[j], 1.0f) * (1.0f / 255.0f); }
                *(u32x4*)(mp + ro * 1024 + bj * 128) = pack8(ma + ga * acc[ai][bj][m][0], mb + gb * acc[ai][bj][m][1]); } }
#undef BR_LOAD
    }
};
struct GluAB { Glu g; BranchAB b;
    __device__ __forceinline__ void scale(f32x4 (&acc)[2][2][4][2], const Unit& u, int wr, int wc, int fr, int fq) const { b.scale(acc, u, wr, wc, fr, fq); }
    __device__ __forceinline__ void operator()(f32x4 (&acc)[2][2][4][2], const Unit& u, int wr, int wc, int fr, int fq) const {
        if (u.aux < 2) g(acc, u, wr, wc, fr, fq); else b(acc, u, wr, wc, fr, fq); }
};
struct OutProj {
    bf16* Z; const uchar* XQa; const uchar* XQb; const float* rs;
    __device__ __forceinline__ void operator()(f32x4 (&acc)[2][2][4][2], const Unit& u, int wr, int wc, int fr, int fq) const {
        constexpr int D = 3; u32x2 L[8][2]; float R[8];
        const int col = u.c0 + wc * 32 + fq * 8; const size_t row = (size_t)(u.r0 + wr * 64 + fr);
        const uchar* xp = (u.r0 < XQ_SPLIT * 256 ? XQa + row * 1024 : XQb + (row - (size_t)XQ_SPLIT * 256) * 1024) + col; bf16* zp = Z + row * 1024 + col; const float* rp = rs + row;
#define OP_LOAD(g) do { const size_t ro = (size_t)(((g) >> 2) * 128 + ((g) & 3) * 16); L[g][0] = *(const u32x2*)(xp + ro * 1024); L[g][1] = *(const u32x2*)(xp + ro * 1024 + 128); R[g] = rp[ro]; } while (0)
#pragma unroll
        for (int g = 0; g < D; ++g) OP_LOAD(g);
#pragma unroll
        for (int g = 0; g < 8; ++g) { const int ai = g >> 2, m = g & 3;
            if (g + D < 8) OP_LOAD(g + D);
            EPI_FENCE;
            const size_t ro = (size_t)(ai * 128 + m * 16); const float as = R[g] * DN_ALPHA, off = -128.0f * as;
#pragma unroll
            for (int bj = 0; bj < 2; ++bj) { u32x2 w = L[g][bj]; w.x ^= 0x80808080u; w.y ^= 0x80808080u; f32x4 xa, xb; unpack8u(w, xa, xb);
                *(u32x4*)(zp + ro * 1024 + bj * 128) = pack8(xa * as + (acc[ai][bj][m][0] + off), xb * as + (acc[ai][bj][m][1] + off)); } }
#undef OP_LOAD
    }
};
struct Moe1 {
    bf16* H;
    __device__ __forceinline__ void operator()(f32x4 (&acc)[2][2][4][2], const Unit& u, int wr, int wc, int fr, int fq) const {
        EPI_FOR_AI_M { const int r = EPI_ROWS(ai, m);
            f32x4 a = acc[ai][0][m][0], b = acc[ai][0][m][1]; const f32x4 ua = acc[ai][1][m][0], ub = acc[ai][1][m][1];
#pragma unroll
            for (int j = 0; j < 4; ++j) { a[j] = a[j] * fast_sigmoid(a[j]) * ua[j]; b[j] = b[j] * fast_sigmoid(b[j]) * ub[j]; }
            *(u32x4*)(H + (size_t)r * 512 + u.c0 + wc * 32 + fq * 8) = pack8(a, b); }
    }
};
struct Moe1_8 {
    bf16* H; const float* rs; const float* cm;
    __device__ __forceinline__ void operator()(f32x4 (&acc)[2][2][4][2], const Unit& u, int wr, int wc, int fr, int fq) const {
        const float* cp = cm + (size_t)u.aux * 1024 + 2 * u.c0 + wc * 32 + fq * 8;
        int vr[8]; float sc[8];
#pragma unroll
        for (int g = 0; g < 8; ++g) vr[g] = u.rows[(g >> 2) * 128 + wr * 64 + (g & 3) * 16 + fr];
#pragma unroll
        for (int g = 0; g < 8; ++g) { const int t = vr[g] - (vr[g] >= XQ_SPLIT * 256 + XQ_VOFF ? XQ_VOFF : 0); sc[g] = rs[t] * (1.0f / 127.0f); }
        EPI_FOR_AI_M { const int r = EPI_ROWS(ai, m); const float s = sc[ai * 4 + m]; const float* cq = cp; asm volatile("" : "+v"(cq));
            const f32x4 cg0 = *(const f32x4*)cq, cg1 = *(const f32x4*)(cq + 4), cu0 = *(const f32x4*)(cq + 128), cu1 = *(const f32x4*)(cq + 132);
            f32x4 a, b;
#pragma unroll
            for (int j = 0; j < 4; ++j) { const float ga = (float)__float_as_int(acc[ai][0][m][0][j]) * (cg0[j] * s), gb = (float)__float_as_int(acc[ai][0][m][1][j]) * (cg1[j] * s);
                a[j] = ga * fast_sigmoid(ga) * ((float)__float_as_int(acc[ai][1][m][0][j]) * (cu0[j] * s)); b[j] = gb * fast_sigmoid(gb) * ((float)__float_as_int(acc[ai][1][m][1][j]) * (cu1[j] * s)); }
            *(u32x4*)(H + (size_t)r * 512 + u.c0 + wc * 32 + fq * 8) = pack8(a, b); EPI_FENCE; }
    }
};
__device__ __forceinline__ unsigned pack4_fp8(const f32x4& a) {
    const float c0 = __builtin_amdgcn_fmed3f(a[0], -448.f, 448.f), c1 = __builtin_amdgcn_fmed3f(a[1], -448.f, 448.f), c2 = __builtin_amdgcn_fmed3f(a[2], -448.f, 448.f), c3 = __builtin_amdgcn_fmed3f(a[3], -448.f, 448.f);
    int w = __builtin_amdgcn_cvt_pk_fp8_f32(c0, c1, 0, false); w = __builtin_amdgcn_cvt_pk_fp8_f32(c2, c3, w, true); return (unsigned)w; }
struct Moe2 {
    uchar* YB;
    __device__ __forceinline__ void operator()(f32x4 (&acc)[2][2][4][2], const Unit& u, int wr, int wc, int fr, int fq) const {
        EPI_FOR_AI_M { uchar* rowp = YB + (size_t)EPI_ROWS(ai, m) * 1024 + u.c0 + wc * 32 + fq * 8;
#pragma unroll
            for (int bj = 0; bj < 2; ++bj) { u32x2 w; w.x = pack4_fp8(acc[ai][bj][m][0]); w.y = pack4_fp8(acc[ai][bj][m][1]); *(u32x2*)(rowp + bj * 128) = w; } }
    }
};
#undef EPI_ROWS
#undef EPI_FOR_AI_M
#undef EPI_FENCE
}
namespace attn {
constexpr int KVBLK = 64, QB = 256, NBUF = 4;
template <int MODE> struct Cfg {
    static constexpr int KPC = MODE == 0 ? 13 : 9;
    static constexpr int KROW = KPC * 16, KBYTES = 64 * KROW, NKI = KPC, VBYTES = 8192, BUF = KBYTES + VBYTES;
    static constexpr int DUMMY = NBUF * BUF;
    static constexpr int NS = MODE == 0 ? 6 : 2;
    static constexpr int NMAP = MODE == 0 ? 1 : 2;
};
__device__ __forceinline__ int crow(int r, int hi) { return (r & 3) + 8 * (r >> 2) + 4 * hi; }
__device__ __forceinline__ s16x4 vtr(const LAS uchar* p) { return __builtin_bit_cast(s16x4, __builtin_amdgcn_ds_read_tr16_b64_v4i16((LAS s16x4*)p)); }
__device__ __forceinline__ void glds_s(const char* sbase, unsigned voff, unsigned lds_dst) {
    unsigned keep; const unsigned d = __builtin_amdgcn_readfirstlane(lds_dst);
    asm volatile("s_mov_b32 %0, m0\n\ts_mov_b32 m0, %3\n\ts_nop 0\n\tglobal_load_lds_dwordx4 %1, %2\n\ts_mov_b32 m0, %0" : "=&s"(keep) : "v"(voff), "s"(sbase), "s"(d) : "memory");
}
__device__ __forceinline__ float max3f(float a, float b, float c) { return fmaxf(fmaxf(a, b), c); }
__device__ __forceinline__ bool unit_of(int i, int G, int c, int& bh, int& qb) {
    const int idx = (i & 1) ? (i * G + (G - 1 - c)) : (i * G + c);
    if (idx >= 2048) return false;
    qb = 15 - (idx >> 7); bh = idx & 127; return true;
}
__device__ __forceinline__ void store_o(bf16* dst, const f32x16 (&o)[2], int hi) {
#pragma unroll
    for (int d0 = 0; d0 < 2; ++d0)
#pragma unroll
        for (int k = 0; k < 4; ++k) { u32x2 w; w.x = cvt_pk_bf16(o[d0][4 * k], o[d0][4 * k + 1]); w.y = cvt_pk_bf16(o[d0][4 * k + 2], o[d0][4 * k + 3]); *(u32x2*)(dst + d0 * 32 + 8 * k + 4 * hi) = w; }
}
#define ATT_THR 8.0f
__device__ __forceinline__ void softmax_step(f32x16& p0, f32x16& p1, float& mrun, float& lrun, f32x16 (&o)[2], bool first, bf16x8 (&pb)[2][2]) {
    float a = max3f(p0[0], p0[1], p0[2]), b = max3f(p1[0], p1[1], p1[2]);
#pragma unroll
    for (int r = 3; r < 15; r += 2) { a = max3f(a, p0[r], p0[r + 1]); b = max3f(b, p1[r], p1[r + 1]); }
    float mx = max3f(a, b, fmaxf(p0[15], p1[15]));
    mx = fmaxf(mx, __shfl_xor(mx, 32));
    if (first || __any(mx > ATT_THR)) {
        const float dl = first ? mx : fmaxf(mx, 0.f); mrun += dl;
        const float alpha = __builtin_amdgcn_exp2f(-dl); lrun *= alpha;
#pragma unroll
        for (int r = 0; r < 16; ++r) { p0[r] -= dl; p1[r] -= dl; o[0][r] *= alpha; o[1][r] *= alpha; }
    }
    float ps = 0.f;
#pragma unroll
    for (int r = 0; r < 16; ++r) { p0[r] = __builtin_amdgcn_exp2f(p0[r]); p1[r] = __builtin_amdgcn_exp2f(p1[r]); ps += p0[r] + p1[r]; }
    lrun += ps;
#pragma unroll
    for (int s = 0; s < 2; ++s) {
        u32x4 w0, w1;
        w0.x = cvt_pk_bf16(p0[8 * s + 0], p0[8 * s + 1]); w0.y = cvt_pk_bf16(p0[8 * s + 2], p0[8 * s + 3]); w0.z = cvt_pk_bf16(p0[8 * s + 4], p0[8 * s + 5]); w0.w = cvt_pk_bf16(p0[8 * s + 6], p0[8 * s + 7]);
        w1.x = cvt_pk_bf16(p1[8 * s + 0], p1[8 * s + 1]); w1.y = cvt_pk_bf16(p1[8 * s + 2], p1[8 * s + 3]); w1.z = cvt_pk_bf16(p1[8 * s + 4], p1[8 * s + 5]); w1.w = cvt_pk_bf16(p1[8 * s + 6], p1[8 * s + 7]);
        pb[0][s] = __builtin_bit_cast(bf16x8, w0); pb[1][s] = __builtin_bit_cast(bf16x8, w1);
    }
}

struct UnitP { const char* kb; const char* vb; int hoff; int NT; int b, h, q0; };
template <int MODE>
__device__ __forceinline__ bool unit_params(int i, int G, int c, const uchar* ws, UnitP& u) {
    int bh, qb; if (!unit_of(i, G, c, bh, qb)) return false;
    u.b = bh >> 3; u.h = bh & 7; u.q0 = qb * 256; u.NT = (u.q0 + QB) / KVBLK; const size_t tb = (size_t)u.b * SEQ;
    if (MODE == 0) { u.kb = (const char*)(ws + WS_KV) + tb * KV_LD * 2; u.vb = u.kb + (u.h * 128 + 64) * 2; u.hoff = u.h * 256; }
    else { u.kb = (const char*)(ws + WS_U1) + tb * U1_LD * 2 + (512 + u.h * 64) * 2; u.vb = (const char*)(ws + WS_U1) + tb * U1_LD * 2 + (1024 + u.h * 64) * 2; u.hoff = 0; }
    return true;
}

template <int MODE>
__device__ __forceinline__ void attn_stream(PT pt, int l, LAS uchar* lds, int c, int G, int vcu) {
    typedef Cfg<MODE> C;
    constexpr int LD = MODE == 0 ? KV_LD : U1_LD;
    constexpr unsigned TSTRIDE = KVBLK * LD * 2;
    const int tid = ltid(), lane = tid & 63, r32 = lane & 31, hi = lane >> 5; const int wid = __builtin_amdgcn_readfirstlane(tid >> 6);
    const uchar* ws = (const uchar*)ldptr(pt, I_WS);
    unsigned voK[2]; bool nope[2];
#pragma unroll
    for (int j = 0; j < 2; ++j) { const int i = wid + 8 * j; const int s = (i < C::NKI ? i : wid) * 64 + lane, row = s / C::KPC, pc = s % C::KPC;
        if (MODE == 0) { nope[j] = pc < 8 || pc == 12; voK[j] = (unsigned)(row * LD + (pc < 8 ? pc * 8 : (pc == 12 ? 0 : 1024 + (pc - 8) * 8))) * 2u; }
        else { nope[j] = false; voK[j] = (unsigned)(row * LD + (pc < 8 ? pc * 8 : 0)) * 2u; } }
    const int vs = wid * 64 + lane;
    const unsigned voV = (unsigned)(((vs & 255) >> 2) * LD + (vs >> 8) * 32 + (vs & 3) * 8) * 2u;
    const unsigned lds0 = (unsigned)(size_t)lds;
    const unsigned dK0 = (unsigned)wid * 1024u, dV = (unsigned)(C::KBYTES + wid * 1024);
    const bool k1real = (wid + 8 < C::NKI); const unsigned dK1 = k1real ? (unsigned)(wid + 8) * 1024u : 0u, dDummy = lds0 + (unsigned)(C::DUMMY + wid * 1024);
    const int kro = r32 * C::KROW + hi * 16;
    const int vro = C::KBYTES + (4 * hi + ((lane & 15) >> 2)) * 64 + (((lane >> 4) & 1) * 16 + (lane & 3) * 4) * 2;
    float lam_val = 0.f, lam_init = 0.f;
    if (MODE == 1) { const float* lam = (const float*)ldptr(pt, I_LAMBDA) + l * 128; lam_init = 0.8f - 0.6f * expf(-0.3f * (float)l); float s1 = 0.f, s2 = 0.f;
        for (int j = 0; j < 32; ++j) { s1 += lam[j] * lam[32 + j]; s2 += lam[64 + j] * lam[96 + j]; }
        lam_val = expf(s1) - expf(s2) + lam_init; }
    const int NGW = G * 8, gw = vcu * 8 + wid; int pj = 0, tilectr = 0;
    constexpr int NGRAN = 32 * (32 * 16 + 16 * 16);
    const float* mo_g = (const float*)ldptr(pt, I_MG) + (size_t)l * 32 * 1024 * 512; const float* mo_u = (const float*)ldptr(pt, I_MU) + (size_t)l * 32 * 1024 * 512; const float* mo_d = (const float*)ldptr(pt, I_MD) + (size_t)l * 32 * 512 * 1024;
    f32x4 bgv[8]; bf16* bgdst = nullptr; uchar* bgdst8 = nullptr; float* bgcm = nullptr; f32x4 bgsc = {0.f, 0.f, 0.f, 0.f}; int bgkind = 0;
    float* mcm = (float*)(const_cast<uchar*>(ws) + WS_MCM); uchar* wm1_8 = const_cast<uchar*>(ws) + WS_WM1;
    const int NBG = NGRAN + ((l + 1 < DEPTH) ? 32 * 512 : 0);
#define BG_MORE() (MODE == 0 && gw + NGW * pj < NBG)
#define BG_LOAD() do { const int g_ = gw + NGW * pj; ++pj; const int cc_ = lane & 15, kr_ = lane >> 4; const float* src_; int ldw_, k0_, n0_; \
        if (g_ < 32 * 512 || g_ >= NGRAN) { const bool mx_ = g_ >= NGRAN; const int gg_ = mx_ ? g_ - NGRAN : g_; const int e_ = gg_ >> 9, r_ = gg_ & 511, nb_ = r_ & 15; k0_ = (r_ >> 4) * 32; n0_ = nb_ * 64; const int nt_ = n0_ >> 8, i_ = n0_ & 255; \
            const size_t lo_ = mx_ ? (size_t)32 * 1024 * 512 : 0; \
            src_ = (i_ < 128 ? mo_g + lo_ + 128 * nt_ + i_ : mo_u + lo_ + 128 * nt_ + (i_ - 128)) + (size_t)e_ * 1024 * 512; ldw_ = 512; \
            bgcm = mcm + (size_t)((mx_ ? l + 1 : l) * 32 + e_) * 1024 + n0_ + 4 * cc_; \
            if (mx_) bgkind = 2; else { bgkind = 0; bgsc = *(const f32x4*)bgcm; bgdst8 = wm1_8 + (size_t)e_ * 1024 * 1024 + (size_t)(n0_ + 4 * cc_) * 1024 + k0_ + 8 * kr_; } } \
        else { const int g2_ = g_ - 32 * 512, e_ = g2_ >> 8, r_ = g2_ & 255, nb_ = r_ & 15; k0_ = (r_ >> 4) * 32; n0_ = nb_ * 64; bgkind = 1; \
            src_ = mo_d + (size_t)e_ * 512 * 1024 + n0_; ldw_ = 1024; bgdst = (bf16*)(ws + WS_WM2) + (size_t)e_ * 1024 * 512 + (size_t)(n0_ + 4 * cc_) * 512 + k0_ + 8 * kr_; } \
        _Pragma("unroll") for (int j_ = 0; j_ < 8; ++j_) bgv[j_] = *(const f32x4*)(src_ + (size_t)(k0_ + 8 * kr_ + j_) * ldw_ + 4 * cc_); } while (0)
#define BG_STORE() do { \
        if (bgkind == 1) { _Pragma("unroll") for (int i_ = 0; i_ < 4; ++i_) { u32x4 o_; o_.x = pk2(bgv[0][i_], bgv[1][i_]); o_.y = pk2(bgv[2][i_], bgv[3][i_]); o_.z = pk2(bgv[4][i_], bgv[5][i_]); o_.w = pk2(bgv[6][i_], bgv[7][i_]); *(u32x4*)(bgdst + (size_t)i_ * 512) = o_; } } \
        else if (bgkind == 0) { _Pragma("unroll") for (int i_ = 0; i_ < 4; ++i_) { const float inv_ = 127.0f / fmaxf(bgsc[i_], 1e-30f); u32x2 o_; \
            o_.x = pack4_i8(bgv[0][i_] * inv_, bgv[1][i_] * inv_, bgv[2][i_] * inv_, bgv[3][i_] * inv_); o_.y = pack4_i8(bgv[4][i_] * inv_, bgv[5][i_] * inv_, bgv[6][i_] * inv_, bgv[7][i_] * inv_); *(u32x2*)(bgdst8 + (size_t)i_ * 1024) = o_; } } \
        else { f32x4 m_; _Pragma("unroll") for (int i_ = 0; i_ < 4; ++i_) { float x_ = fabsf(bgv[0][i_]); _Pragma("unroll") for (int j_ = 1; j_ < 8; ++j_) x_ = fmaxf(x_, fabsf(bgv[j_][i_])); x_ = fmaxf(x_, __shfl_xor(x_, 16)); x_ = fmaxf(x_, __shfl_xor(x_, 32)); m_[i_] = x_; } \
            if (lane < 16) { _Pragma("unroll") for (int i_ = 0; i_ < 4; ++i_) atomicMax((int*)(bgcm + i_), __float_as_int(m_[i_])); } } } while (0)
    UnitP cu, nu; int ci = 0, pi = 0;
    if (!unit_params<MODE>(0, G, c, ws, cu)) return;
    const char* pk = cu.kb; const char* pv = cu.vb; int prem = cu.NT; bool pvalid = true;
    unsigned pvo0 = voK[0] + (nope[0] ? (unsigned)cu.hoff : 0u), pvo1 = voK[1] + (nope[1] ? (unsigned)cu.hoff : 0u);
    unsigned nbuf = 0;
#define ATT_ISSUE() do { const unsigned _b = lds0 + nbuf * (unsigned)C::BUF; const unsigned _d0 = __builtin_amdgcn_readfirstlane(_b + dK0), _d1 = __builtin_amdgcn_readfirstlane(k1real ? _b + dK1 : dDummy), _d2 = __builtin_amdgcn_readfirstlane(_b + dV); unsigned _keep; \
        asm volatile("s_mov_b32 %0, m0\n\ts_mov_b32 m0, %4\n\ts_nop 0\n\tglobal_load_lds_dwordx4 %1, %7\n\ts_mov_b32 m0, %5\n\ts_nop 0\n\tglobal_load_lds_dwordx4 %2, %7\n\ts_mov_b32 m0, %6\n\ts_nop 0\n\tglobal_load_lds_dwordx4 %3, %8\n\ts_mov_b32 m0, %0" \
            : "=&s"(_keep) : "v"(pvo0), "v"(pvo1), "v"(voV), "s"(_d0), "s"(_d1), "s"(_d2), "s"(pk), "s"(pv) : "memory"); \
        nbuf = (nbuf + 1) & (NBUF - 1); \
        if (pvalid) { if (--prem == 0) { if (unit_params<MODE>(pi + 1, G, c, ws, nu)) { ++pi; pk = nu.kb; pv = nu.vb; prem = nu.NT; pvo0 = voK[0] + (nope[0] ? (unsigned)nu.hoff : 0u); pvo1 = voK[1] + (nope[1] ? (unsigned)nu.hoff : 0u); } else { pvalid = false; } } \
                      else { pk += TSTRIDE; pv += TSTRIDE; } } } while (0)
    ATT_ISSUE(); ATT_ISSUE(); ATT_ISSUE();
    asm volatile("s_waitcnt vmcnt(6)" ::: "memory"); __builtin_amdgcn_s_barrier(); asm volatile("" ::: "memory");
    unsigned cbuf = 0;
    for (;;) {
        const size_t tq = (size_t)cu.b * SEQ + cu.q0 + wid * 32 + r32;
        bf16x8 qf[C::NMAP][C::NS];
        if (MODE == 0) { const bf16* qp = (const bf16*)(ws + WS_Q) + tq * 768 + cu.h * 96;
#pragma unroll
            for (int s = 0; s < C::NS; ++s) qf[0][s] = *(const bf16x8*)(qp + s * 16 + hi * 8); }
        else { const bf16* qp = (const bf16*)(ws + WS_U1) + tq * U1_LD + cu.h * 64;
#pragma unroll
            for (int mp = 0; mp < C::NMAP; ++mp)
#pragma unroll
                for (int s = 0; s < C::NS; ++s) qf[mp][s] = *(const bf16x8*)(qp + mp * 32 + s * 16 + hi * 8); }
#pragma unroll
        for (int mp = 0; mp < C::NMAP; ++mp)
#pragma unroll
            for (int s = 0; s < C::NS; ++s) asm volatile("" : "+v"(qf[mp][s]));
        float mrun[C::NMAP], lrun[C::NMAP]; f32x16 o[C::NMAP][2], negm[C::NMAP];
#pragma unroll
        for (int mp = 0; mp < C::NMAP; ++mp) { mrun[mp] = 0.f; lrun[mp] = 0.f; o[mp][0] = f32x16{}; o[mp][1] = f32x16{}; negm[mp] = f32x16{}; }
        const int qabs = cu.q0 + wid * 32 + r32;
        const int last_tile = (cu.q0 + wid * 32 + 31) / KVBLK;
        const int first_band = (cu.q0 + wid * 32) / KVBLK;
#define ATT_TILE(MASKED) do { \
                bf16x8 pb[C::NMAP][2][2]; \
_Pragma("unroll") \
                for (int mp = 0; mp < C::NMAP; ++mp) { \
                    f32x16 p0, p1; \
                    { bf16x8 ka[C::NS], kb[C::NS];            \
_Pragma("unroll") \
                    for (int s = 0; s < C::NS; ++s) { ka[s] = *(const LAS bf16x8*)(buf + kro + mp * 64 + s * 32); kb[s] = *(const LAS bf16x8*)(buf + kro + 32 * C::KROW + mp * 64 + s * 32); } \
                    __builtin_amdgcn_sched_barrier(0); \
_Pragma("unroll") \
                    for (int s = 0; s < C::NS; ++s) { \
                        p0 = __builtin_amdgcn_mfma_f32_32x32x16_bf16(ka[s], qf[mp][s], s == 0 ? negm[mp] : p0, 0, 0, 0); \
                        p1 = __builtin_amdgcn_mfma_f32_32x32x16_bf16(kb[s], qf[mp][s], s == 0 ? negm[mp] : p1, 0, 0, 0); \
                    } } \
                    if (MASKED) {                                         \
                        const int kb0 = kt * KVBLK; \
_Pragma("unroll") \
                        for (int r = 0; r < 16; ++r) { const int kv = kb0 + crow(r, hi); if (kv > qabs) p0[r] = -1e30f; if (kv + 32 > qabs) p1[r] = -1e30f; } \
                    } \
                     \
                    float a = max3f(p0[0], p0[1], p0[2]), b = max3f(p1[0], p1[1], p1[2]); \
_Pragma("unroll") \
                    for (int r = 3; r < 15; r += 2) { a = max3f(a, p0[r], p0[r + 1]); b = max3f(b, p1[r], p1[r + 1]); } \
                    float mx = max3f(a, b, fmaxf(p0[15], p1[15])); \
                    mx = fmaxf(mx, __shfl_xor(mx, 32)); \
                    if (kt == 0 || __any(mx > ATT_THR)) { \
                        const float dl = (kt == 0) ? mx : fmaxf(mx, 0.f); mrun[mp] += dl; \
                        const float alpha = __builtin_amdgcn_exp2f(-dl); lrun[mp] *= alpha; \
_Pragma("unroll") \
                        for (int r = 0; r < 16; ++r) { p0[r] -= dl; p1[r] -= dl; o[mp][0][r] *= alpha; o[mp][1][r] *= alpha; negm[mp][r] = -mrun[mp]; } \
                    } \
                    float ps = 0.f; \
_Pragma("unroll") \
                    for (int r = 0; r < 16; ++r) { p0[r] = __builtin_amdgcn_exp2f(p0[r]); p1[r] = __builtin_amdgcn_exp2f(p1[r]); ps += p0[r] + p1[r]; } \
                    lrun[mp] += ps; \
_Pragma("unroll") \
                    for (int s = 0; s < 2; ++s) { \
                        u32x4 w0, w1; \
                        w0.x = cvt_pk_bf16(p0[8 * s + 0], p0[8 * s + 1]); w0.y = cvt_pk_bf16(p0[8 * s + 2], p0[8 * s + 3]); w0.z = cvt_pk_bf16(p0[8 * s + 4], p0[8 * s + 5]); w0.w = cvt_pk_bf16(p0[8 * s + 6], p0[8 * s + 7]); \
                        w1.x = cvt_pk_bf16(p1[8 * s + 0], p1[8 * s + 1]); w1.y = cvt_pk_bf16(p1[8 * s + 2], p1[8 * s + 3]); w1.z = cvt_pk_bf16(p1[8 * s + 4], p1[8 * s + 5]); w1.w = cvt_pk_bf16(p1[8 * s + 6], p1[8 * s + 7]); \
                        pb[mp][0][s] = __builtin_bit_cast(bf16x8, w0); pb[mp][1][s] = __builtin_bit_cast(bf16x8, w1); \
                    } \
                } \
_Pragma("unroll") \
                for (int d0 = 0; d0 < 2; ++d0) \
_Pragma("unroll") \
                    for (int x = 0; x < 2; ++x) \
_Pragma("unroll") \
                        for (int s = 0; s < 2; ++s) { \
                            const s16x4 lo = vtr(buf + vro + d0 * 4096 + (32 * x + 16 * s) * 64), hh = vtr(buf + vro + d0 * 4096 + (32 * x + 16 * s + 8) * 64); \
                            const bf16x8 vf = (bf16x8){lo[0], lo[1], lo[2], lo[3], hh[0], hh[1], hh[2], hh[3]}; \
_Pragma("unroll") \
                            for (int mp = 0; mp < C::NMAP; ++mp) o[mp][d0] = __builtin_amdgcn_mfma_f32_32x32x16_bf16(vf, pb[mp][x][s], o[mp][d0], 0, 0, 0); \
                        } \
        } while (0)
        int kt = 0;
#define ATT_HEAD() ATT_ISSUE(); const LAS uchar* buf = lds + cbuf * C::BUF
#define ATT_TAIL() asm volatile("s_waitcnt vmcnt(6) lgkmcnt(0)" ::: "memory"); __builtin_amdgcn_s_barrier(); asm volatile("" ::: "memory"); cbuf = (cbuf + 1) & (NBUF - 1)
#pragma unroll 1
        for (; kt < first_band; ++kt) { ATT_HEAD(); const bool bg_ = ((tilectr++ & 7) == 0) && BG_MORE(); if (bg_) BG_LOAD(); ATT_TILE(false); if (bg_) BG_STORE(); ATT_TAIL(); }
#pragma unroll 1
        for (; kt <= last_tile; ++kt) { ATT_HEAD(); ATT_TILE(true); ATT_TAIL(); }
#pragma unroll 1
        for (; kt < cu.NT; ++kt) { ATT_ISSUE(); ATT_TAIL(); }
#undef ATT_HEAD
#undef ATT_TAIL
#undef ATT_TILE
        bf16* O3 = (bf16*)(ws + WS_O3);
#pragma unroll
        for (int mp = 0; mp < C::NMAP; ++mp) { lrun[mp] += __shfl_xor(lrun[mp], 32); const float rl = 1.0f / lrun[mp];
#pragma unroll
            for (int r = 0; r < 16; ++r) { o[mp][0][r] *= rl; o[mp][1][r] *= rl; } }
        if (MODE == 0) store_o(O3 + tq * O3_LD + cu.h * 64, o[0], hi);
        else {
            const float* subln = (const float*)ldptr(pt, I_SUBLN) + l * 64;
            float ss = 0.f;
#pragma unroll
            for (int d0 = 0; d0 < 2; ++d0)
#pragma unroll
                for (int r = 0; r < 16; ++r) { const float v = o[0][d0][r] - lam_val * o[C::NMAP - 1][d0][r]; o[0][d0][r] = v; ss += v * v; }
            ss += __shfl_xor(ss, 32);
            const float rs = rsqrtf(ss * (1.0f / 64.0f) + 1e-5f) * (1.0f - lam_init);
#pragma unroll
            for (int d0 = 0; d0 < 2; ++d0)
#pragma unroll
                for (int r = 0; r < 16; ++r) o[0][d0][r] *= rs * subln[d0 * 32 + crow(r, hi)];
            store_o(O3 + tq * O3_LD + 512 + cu.h * 64, o[0], hi);
        }
        ++ci;
        if (!unit_params<MODE>(ci, G, c, ws, cu)) break;
    }
    while (BG_MORE()) { BG_LOAD(); BG_STORE(); }
    asm volatile("s_waitcnt vmcnt(0)" ::: "memory"); __builtin_amdgcn_s_barrier(); asm volatile("" ::: "memory");
#undef BG_MORE
#undef BG_LOAD
#undef BG_STORE
#undef ATT_ISSUE
}
#undef ATT_THR
}
template <class ColPtr>
__device__ __forceinline__ void xpose_item(const ColPtr& cp, int ldw, int ksrc, const float* kscale, bf16* WT, int Kd, int item, int nblk, LAS float* scr, int lane) {
    const int kb = item / nblk, nb = item % nblk, k0 = 64 * kb, n0 = 32 * nb;
    const float* src = cp(n0 + (lane & 31));
#pragma unroll 8
    for (int i = 0; i < 32; ++i) { const int kk = 2 * i + (lane >> 5), k = k0 + kk; float v = 0.f;
        if (src != nullptr && k < ksrc) { v = src[(size_t)k * ldw]; if (kscale) v *= kscale[k]; }
        scr[kk * 33 + (lane & 31)] = v; }
    LDS_WAIT(); asm volatile("" ::: "memory");
    const int c = lane & 7;
#pragma unroll
    for (int j = 0; j < 4; ++j) { const int n = (lane >> 3) + 8 * j; const LAS float* s = scr + (8 * c) * 33 + n;
        u32x4 o; o.x = pk2(s[0 * 33], s[1 * 33]); o.y = pk2(s[2 * 33], s[3 * 33]); o.z = pk2(s[4 * 33], s[5 * 33]); o.w = pk2(s[6 * 33], s[7 * 33]);
        *(u32x4*)(WT + (size_t)(n0 + n) * Kd + k0 + 8 * c) = o; }
    LDS_WAIT(); asm volatile("" ::: "memory");
}
__device__ __forceinline__ void xpose64(const float* src, int ldw, int ksrc, const float* kscale, bf16* WT, int Kd, int n0, int k0, int lane) {
    const int c = lane & 15, kr = lane >> 4, kb = k0 + 16 * kr;
    f32x4 v[16];
    if (src != nullptr && kb < ksrc) {
#pragma unroll
        for (int j = 0; j < 16; ++j) v[j] = *(const f32x4*)(src + (size_t)(kb + j) * ldw + 4 * c);
        if (kscale) {
#pragma unroll
            for (int j = 0; j < 16; ++j) v[j] *= kscale[kb + j];
        }
    } else {
#pragma unroll
        for (int j = 0; j < 16; ++j) v[j] = (f32x4){0.f, 0.f, 0.f, 0.f};
    }
#pragma unroll
    for (int i = 0; i < 4; ++i) { bf16* row = WT + (size_t)(n0 + 4 * c + i) * Kd + kb;
#pragma unroll
        for (int h = 0; h < 2; ++h) { u32x4 o; o.x = pk2(v[8 * h + 0][i], v[8 * h + 1][i]); o.y = pk2(v[8 * h + 2][i], v[8 * h + 3][i]); o.z = pk2(v[8 * h + 4][i], v[8 * h + 5][i]); o.w = pk2(v[8 * h + 6][i], v[8 * h + 7][i]);
            *(u32x4*)(row + 8 * h) = o; } }
}
__device__ __forceinline__ int rope_perm(int j) { return (j & 1) ? 16 + (j >> 1) : (j >> 1); }
struct CpWin { const float* W; __device__ __forceinline__ const float* operator()(int n) const {
    if (n < 512) return W + 416 + n; if (n < 1024) return W + 928 + (n - 512); if (n < 1536) return W + 1440 + (n - 1024); if (n < 1792) return W + (n - 1536);
    if (n < 1920) return W + 256 + (n - 1792); if (n < 1952) return W + 384 + rope_perm(n - 1920); if (n < 2048) return nullptr; return W + 1952 + (n - 2048); } };
struct CpOff { const float* W; __device__ __forceinline__ const float* operator()(int n) const { return W + n; } };
struct CpWuq { const float* W; __device__ __forceinline__ const float* operator()(int n) const { const int h = n / 96, c = n % 96; return W + h * 96 + (c < 64 ? c : 64 + rope_perm(c - 64)); } };
struct CpGlu { const float* W; __device__ __forceinline__ const float* operator()(int n) const { const int nt = n >> 8, i = n & 255; return W + (i < 128 ? 128 * nt + i : 1024 + 128 * nt + (i - 128)); } };
struct CpMoe1 { const float* Wg; const float* Wu; __device__ __forceinline__ const float* operator()(int n) const { const int nt = n >> 8, i = n & 255; return i < 128 ? Wg + 128 * nt + i : Wu + 128 * nt + (i - 128); } };

__device__ __forceinline__ void moe_colmax_pass(PT pt, int l, int vcu, int G) {
    const int tid = ltid(), lane = tid & 63, wave = __builtin_amdgcn_readfirstlane(tid >> 6), cc = lane & 15, kr = lane >> 4;
    uchar* ws = (uchar*)ldptr(pt, I_WS); float* mcm = (float*)(ws + WS_MCM);
    const float* mo_g = (const float*)ldptr(pt, I_MG) + (size_t)l * 32 * 1024 * 512; const float* mo_u = (const float*)ldptr(pt, I_MU) + (size_t)l * 32 * 1024 * 512;
    for (int g = vcu * 8 + wave; g < 32 * 512; g += G * 8) {
        const int e = g >> 9, r = g & 511, nb = r & 15, k0 = (r >> 4) * 32, n0 = nb * 64, nt = n0 >> 8, i = n0 & 255;
        const float* src = (i < 128 ? mo_g + 128 * nt + i : mo_u + 128 * nt + (i - 128)) + (size_t)e * 1024 * 512;
        f32x4 v[8];
#pragma unroll
        for (int j = 0; j < 8; ++j) v[j] = *(const f32x4*)(src + (size_t)(k0 + 8 * kr + j) * 512 + 4 * cc);
        float* cm = mcm + (size_t)(l * 32 + e) * 1024 + n0 + 4 * cc;
#pragma unroll
        for (int q = 0; q < 4; ++q) { float x = fabsf(v[0][q]);
#pragma unroll
            for (int j = 1; j < 8; ++j) x = fmaxf(x, fabsf(v[j][q]));
            x = fmaxf(x, __shfl_xor(x, 16)); x = fmaxf(x, __shfl_xor(x, 32));
            if (lane < 16) atomicMax((int*)(cm + q), __float_as_int(x)); }
    }
}
__device__ __forceinline__ void quant_row(uchar* ws, int t, const float (&v)[16], int lane) {
    float m = 0.f;
#pragma unroll
    for (int j = 0; j < 16; ++j) m = fmaxf(m, fabsf(v[j]));
    m = fmaxf(wave_max(m), 1e-30f); const float inv = 127.0f / m;
    uchar* row = (t < XQ_SPLIT * 256) ? ws + WS_XQ1 + (size_t)t * 1024 : ws + WS_XQ2 + (size_t)(t - XQ_SPLIT * 256) * 1024;
    u32x2 a, b; a.x = pack4_i8(v[0] * inv, v[1] * inv, v[2] * inv, v[3] * inv); a.y = pack4_i8(v[4] * inv, v[5] * inv, v[6] * inv, v[7] * inv);
    b.x = pack4_i8(v[8] * inv, v[9] * inv, v[10] * inv, v[11] * inv); b.y = pack4_i8(v[12] * inv, v[13] * inv, v[14] * inv, v[15] * inv);
    *(u32x2*)(row + 8 * lane) = a; *(u32x2*)(row + 512 + 8 * lane) = b;
    if (lane == 0) ((float*)(ws + WS_XRS))[t] = m * (1.0f / 127.0f);
}
__device__ __forceinline__ void prep_phase(PT pt, int l, LAS uchar* lds, int vcu, int G) {
    const int tid = ltid(), lane = tid & 63, wave = __builtin_amdgcn_readfirstlane(tid >> 6);
    uchar* ws = (uchar*)ldptr(pt, I_WS);
    {
        LAS f32x2* apow = (LAS f32x2*)lds;
        LAS f32x2* bbar = apow + 17 * 64;
        LAS f32x2* cm = bbar + 64 * 16;
        LAS float* kk = (LAS float*)(cm + 16 * 64);
        const float* are = (const float*)ldptr(pt, I_ARE) + (size_t)l * 32 * 64; const float* aim = (const float*)ldptr(pt, I_AIM) + (size_t)l * 32 * 64; const float* ldt = (const float*)ldptr(pt, I_LOGDT) + l * 32;
        const float* bre = (const float*)ldptr(pt, I_BRE) + (size_t)l * 32 * 1024; const float* bim = (const float*)ldptr(pt, I_BIM) + (size_t)l * 32 * 1024;
        const float* cre = (const float*)ldptr(pt, I_CRE) + (size_t)l * 32 * 1024; const float* cim = (const float*)ldptr(pt, I_CIM) + (size_t)l * 32 * 1024;
        for (int g = vcu; g < 32; g += G) {
            const float dt = expf(ldt[g]);
            for (int i = tid; i < 17 * 64; i += 512) { const int k = i >> 6, n = i & 63; const float ar = are[g * 64 + n] * dt * (float)k, ai = aim[g * 64 + n] * dt * (float)k; const float e = expf(ar); float sn, cs; sincosf(ai, &sn, &cs); apow[i] = (f32x2){e * cs, e * sn}; }
            for (int i = tid; i < 1024; i += 512) { const int n = i >> 4;
                const float Ar = are[g * 64 + n], Ai = aim[g * 64 + n]; const float e = expf(Ar * dt); float sn, cs; sincosf(Ai * dt, &sn, &cs);
                const float nr = e * cs - 1.0f, ni = e * sn, den = 1.0f / (Ar * Ar + Ai * Ai); const float fr_ = (nr * Ar + ni * Ai) * den, fi_ = (ni * Ar - nr * Ai) * den;
                const float br = bre[g * 1024 + i], bi = bim[g * 1024 + i]; bbar[i] = (f32x2){fr_ * br - fi_ * bi, fr_ * bi + fi_ * br};
                cm[i] = (f32x2){cre[g * 1024 + i], cim[g * 1024 + i]}; }
            __syncthreads();
            for (int i = tid; i < 4096; i += 512) { const int k = i >> 8, p = (i >> 4) & 15, q = i & 15; float s = 0.f;
                for (int n = 0; n < 64; ++n) { const f32x2 c = cm[p * 64 + n], ak = apow[k * 64 + n], b = bbar[n * 16 + q]; const float zr = c.x * ak.x - c.y * ak.y, zi = c.x * ak.y + c.y * ak.x; s += zr * b.x - zi * b.y; }
                kk[i] = s; }
            __syncthreads();
            bf16* wy = (bf16*)(ws + W_SY) + (size_t)g * 256 * 384; bf16* wsm = (bf16*)(ws + W_SS) + (size_t)g * 256 * 256;
            for (int i = tid; i < 256 * 384 / 2; i += 512) { const int row = (2 * i) / 384, k0 = (2 * i) % 384; const int ii = row >> 4, p = row & 15; float v[2];
#pragma unroll
                for (int e = 0; e < 2; ++e) { const int k = k0 + e;
                    if (k < 256) { const int j = k >> 4, q = k & 15; v[e] = (j <= ii) ? kk[((ii - j) * 16 + p) * 16 + q] : 0.f; }
                    else { const int n = (k - 256) & 63; const f32x2 c = cm[p * 64 + n], ak = apow[(ii + 1) * 64 + n]; v[e] = (k < 320) ? (c.x * ak.x - c.y * ak.y) : -(c.x * ak.y + c.y * ak.x); } }
                *(unsigned*)(wy + (size_t)row * 384 + k0) = pk2(v[0], v[1]); }
            for (int i = tid; i < 256 * 256 / 2; i += 512) { const int row = (2 * i) >> 8, k0 = (2 * i) & 255; float v[2];
#pragma unroll
                for (int e = 0; e < 2; ++e) { const int k = k0 + e, j = k >> 4, q = k & 15;
                    if (row < 128) { const int n = row >> 1; const f32x2 ak = apow[(15 - j) * 64 + n], b = bbar[n * 16 + q]; v[e] = (row & 1) ? (ak.x * b.y + ak.y * b.x) : (ak.x * b.x - ak.y * b.y); } else v[e] = 0.f; }
                *(unsigned*)(wsm + (size_t)row * 256 + k0) = pk2(v[0], v[1]); }
            if (tid < 64) ((f32x2*)(ws + WS_A16))[g * 64 + tid] = apow[16 * 64 + tid];
            __syncthreads();
        }
    }
    {
        const float* win_ = (const float*)ldptr(pt, I_WIN) + (size_t)l * 1024 * IN_WIDTH;
        LAS float* cmx = (LAS float*)lds;
        const int c = tid & 63, kq = tid >> 6;
        for (int cb = (vcu + G - (32 % G)) % G; cb < 48 + 40; cb += G) {
            const bool gate = cb < 48; const int n = (gate ? cb : cb - 48) * 64 + c;
            const float* src = gate ? win_ + 2464 + n : CpWin{win_}(n); float mx = 0.f;
            if (src) for (int k = kq * 128; k < kq * 128 + 128; ++k) mx = fmaxf(mx, fabsf(src[(size_t)k * IN_WIDTH]));
            cmx[kq * 64 + c] = mx;
            __syncthreads();
            float m = cmx[c];
#pragma unroll
            for (int q = 1; q < 8; ++q) m = fmaxf(m, cmx[q * 64 + c]);
            m = fmaxf(m, 1e-30f); const float inv = 127.0f / m;
            if (kq == 0) ((float*)(ws + (gate ? WS_GCS : WS_ICS)))[n] = m * (1.0f / 127.0f);
            uchar* dst = ws + (gate ? W_G : W_IN) + (size_t)n * 1024 + kq * 128;
            for (int k0 = 0; k0 < 128; k0 += 16) { u32x4 o; unsigned w[4];
#pragma unroll
                for (int q = 0; q < 4; ++q) { if (src) { const float* s4 = src + (size_t)(kq * 128 + k0 + 4 * q) * IN_WIDTH; w[q] = pack4_i8(s4[0] * inv, s4[IN_WIDTH] * inv, s4[2 * (size_t)IN_WIDTH] * inv, s4[3 * (size_t)IN_WIDTH] * inv); } else w[q] = 0u; }
                o.x = w[0]; o.y = w[1]; o.z = w[2]; o.w = w[3]; *(u32x4*)(dst + k0) = o; }
            __syncthreads();
        }
    }
    {
        LAS float* scr = (LAS float*)(lds + wave * 16384);
        const int gw = vcu * 8 + wave, NGW = G * 8;
        const float* win = (const float*)ldptr(pt, I_WIN) + (size_t)l * 1024 * IN_WIDTH;
        constexpr int F0 = 0, F1 = 0  , F3 = 2 * 16, F4 = 8 * 16, F5 = 8 * 16, F6 = 8 * 32, F7 = 16 * 16, S2 = 4 * 24, S0 = 0;
        constexpr int NIT = F0 + F1 + F3 + F4 + F5 + F6 + F7 + S2 + S0;
        for (int it = gw; it < NIT; it += NGW) { int r = it;
            if (r < F0) { const int kb = r / 40, nb = r % 40; if (nb != 30) xpose64(CpWin{win}(nb * 64), IN_WIDTH, 1024, nullptr, (bf16*)(ws + W_IN), 1024, nb * 64, kb * 64, lane); continue; } r -= F0;
            if (r < F1) { const int kb = r / 48, nb = r % 48; xpose64(win + 2464 + nb * 64, IN_WIDTH, 1024, nullptr, (bf16*)(ws + W_G), 1024, nb * 64, kb * 64, lane); continue; } r -= F1;
            if (r < F3) { const int kb = r / 16, nb = r % 16; xpose64((const float*)ldptr(pt, I_WUKV) + (size_t)l * 128 * 1024 + nb * 64, 1024, 128, (const float*)ldptr(pt, I_KVNORM) + l * 128, (bf16*)(ws + W_UKV), 128, nb * 64, kb * 64, lane); continue; } r -= F3;
            if (r < F4) { const int kb = r / 16, nb = r % 16; xpose64((const float*)ldptr(pt, I_WAOUT) + (size_t)l * 512 * 1024 + nb * 64, 1024, 512, nullptr, (bf16*)(ws + W_A), 1024, nb * 64, kb * 64, lane); continue; } r -= F4;
            if (r < F5) { const int kb = r / 16, nb = r % 16; xpose64((const float*)ldptr(pt, I_WBOUT) + (size_t)l * 512 * 1024 + nb * 64, 1024, 512, nullptr, (bf16*)(ws + W_A) + 512, 1024, nb * 64, kb * 64, lane); continue; } r -= F5;
            if (r < F6) { const int kb = r / 32, nb = r % 32; xpose64(CpGlu{(const float*)ldptr(pt, I_WGLU) + (size_t)l * 512 * 2048}(nb * 64), 2048, 512, nullptr, (bf16*)(ws + W_GLU2), 1024, nb * 64, kb * 64, lane); continue; } r -= F6;
            if (r < F7) { const int kb = r / 16, nb = r % 16; xpose64((const float*)ldptr(pt, I_WO) + (size_t)l * 1024 * 1024 + nb * 64, 1024, 1024, nullptr, (bf16*)(ws + W_O), 1024, nb * 64, kb * 64, lane); continue; } r -= F7;
            if (r < S2) { xpose_item(CpWuq{(const float*)ldptr(pt, I_WUQ) + (size_t)l * 256 * 768}, 768, 256, (const float*)ldptr(pt, I_QNORM) + l * 256, (bf16*)(ws + W_UQ), 256, r, 24, scr, lane); continue; } r -= S2;
        }
    }
    if (l == 0) {
        const float* x = (const float*)ldptr(pt, I_X); bf16* xb = (bf16*)(ws + WS_XB);
        const size_t stride = (size_t)G * 512;
        for (int t = vcu * 8 + wave; t < T; t += G * 8) { float v[16];
#pragma unroll
            for (int hf = 0; hf < 2; ++hf) { const float* xr = x + (size_t)t * 1024 + hf * 512 + 8 * lane; const f32x4 v0 = *(const f32x4*)xr, v1 = *(const f32x4*)(xr + 4);
#pragma unroll
                for (int j = 0; j < 4; ++j) { v[hf * 8 + j] = v0[j]; v[hf * 8 + 4 + j] = v1[j]; } }
            quant_row(ws, t, v, lane); }
        { const float* rw = (const float*)ldptr(pt, I_RW); bf16* rwh = (bf16*)(ws + WS_RWH); bf16* rwl = (bf16*)(ws + WS_RWL);
          for (size_t i = (size_t)vcu * 512 + tid; i < 32 * 1024; i += stride) { const int e = (int)(i >> 10), k = (int)(i & 1023); const float w = rw[k * 32 + e]; const unsigned h = f2bf(w); rwh[i] = (bf16)h; rwl[i] = (bf16)f2bf(w - __uint_as_float(h << 16)); } }
        const int* pos = (const int*)ldptr(pt, I_POS); f32x2* ra = (f32x2*)(ws + WS_ROPEA); f32x2* rb = (f32x2*)(ws + WS_ROPEB);
        for (size_t i = (size_t)vcu * 512 + tid; i < (size_t)T * 20; i += stride) { const int t = (int)(i / 20), j = (int)(i % 20);
            const float p = (float)pos[t]; float inv; if (j < 16) inv = powf(500000.0f, -(float)(2 * j) / 32.0f); else inv = powf(500000.0f, -(float)(2 * (j - 16)) / 8.0f);
            const float ang = p * inv; float sn, cs; sincosf(ang, &sn, &cs);
            if (j < 16) ra[(size_t)t * 16 + j] = (f32x2){cs, sn}; else rb[(size_t)t * 4 + (j - 16)] = (f32x2){cs, sn}; }
    }
}
__device__ __forceinline__ void prep_moe(PT pt, int l, LAS uchar* lds, int vcu, int G) {
    const int tid = ltid(), lane = tid & 63, wave = __builtin_amdgcn_readfirstlane(tid >> 6);
    LAS float* scr = (LAS float*)(lds + wave * 16384);
    const int gw = vcu * 8 + wave, NGW = G * 8;
    const float* wg = (const float*)ldptr(pt, I_MG) + (size_t)l * 32 * 1024 * 512; const float* wu = (const float*)ldptr(pt, I_MU) + (size_t)l * 32 * 1024 * 512; const float* wd = (const float*)ldptr(pt, I_MD) + (size_t)l * 32 * 512 * 1024;
    constexpr int J1 = 16 * 16, J2 = 8 * 16;
    for (int it = gw; it < 32 * (J1 + J2); it += NGW) {
        if (it < 32 * J1) { const int e = it / J1, r = it % J1, kb = r / 16, nb = r % 16; xpose64(CpMoe1{wg + (size_t)e * 1024 * 512, wu + (size_t)e * 1024 * 512}(nb * 64), 512, 1024, nullptr, (bf16*)(((uchar*)ldptr(pt, I_WS)) + WS_WM1) + (size_t)e * 1024 * 1024, 1024, nb * 64, kb * 64, lane); }
        else { const int e = (it - 32 * J1) / J2, r = (it - 32 * J1) % J2, kb = r / 16, nb = r % 16; xpose64(wd + (size_t)e * 512 * 1024 + nb * 64, 1024, 512, nullptr, (bf16*)(((uchar*)ldptr(pt, I_WS)) + WS_WM2) + (size_t)e * 1024 * 512, 512, nb * 64, kb * 64, lane); }
    }
}

__device__ __forceinline__ void scan_phase(PT pt, int vcu, int G) {
    const int tid = ltid(), lane = tid & 63, wave = __builtin_amdgcn_readfirstlane(tid >> 6);
    const unsigned* S = (const unsigned*)(((uchar*)ldptr(pt, I_WS)) + WS_S); bf16* UC = (bf16*)(((uchar*)ldptr(pt, I_WS)) + WS_UC); const f32x2* A16 = (const f32x2*)(((uchar*)ldptr(pt, I_WS)) + WS_A16);
    for (int task = vcu + G * wave; task < 512; task += G * 8) {
        const int b = task >> 5, g = task & 31;
        const f32x2 aa = A16[g * 64 + lane]; float hr = 0.f, hi_ = 0.f;
        const size_t row0 = (size_t)g * NCHUNK + (size_t)b * 256;
        unsigned s0[32], s1[32];
#define SC_LOAD(SV, C0) _Pragma("unroll") for (int j = 0; j < 32; ++j) SV[j] = S[(row0 + (C0) + j) * 64 + lane];
#define SC_STEPS(SV, C0) _Pragma("unroll") for (int j = 0; j < 32; ++j) { bf16* up = UC + (row0 + (C0) + j) * UC_LD + 256 + lane; up[0] = (bf16)f2bf(hr); up[64] = (bf16)f2bf(hi_); \
                const float nr = aa.x * hr - aa.y * hi_ + bflo(SV[j]), ni = aa.x * hi_ + aa.y * hr + bfhi(SV[j]); hr = nr; hi_ = ni; }
        SC_LOAD(s0, 0);
#pragma unroll 1
        for (int c0 = 0; c0 < 256; c0 += 64) {
            SC_LOAD(s1, c0 + 32);
            SC_STEPS(s0, c0);
            if (c0 + 64 < 256) { SC_LOAD(s0, c0 + 64); }
            SC_STEPS(s1, c0 + 32);
        }
#undef SC_LOAD
#undef SC_STEPS
    }
}

__device__ __forceinline__ void attn_phase(PT pt, int l, LAS uchar* lds, int c, int G, int vcu) {
    attn::attn_stream<0>(pt, l, lds, c, G, vcu);
    attn::attn_stream<1>(pt, l, lds, c, G, vcu);
}
constexpr int RW_ROW = 1040;
__device__ __forceinline__ void ln1_router_phase(PT pt, int l, LAS uchar* lds, int vcu, int G) {
    const int tid = ltid(), lane = tid & 63, r32 = lane & 31, hi = lane >> 5, wave = __builtin_amdgcn_readfirstlane(tid >> 6);
    uchar* ws = (uchar*)ldptr(pt, I_WS);
    const bf16* Z = (const bf16*)(ws + WS_Z); bf16* XB = (bf16*)(ws + WS_XB);
    const float* gain = (const float*)ldptr(pt, I_LNG) + (size_t)(l * 2 + 0) * 1024; const float* bias = (const float*)ldptr(pt, I_LNB) + (size_t)(l * 2 + 0) * 1024;
    const float* rbias = (const float*)ldptr(pt, I_RB);
    const bf16* RWH = (const bf16*)(ws + WS_RWH); const bf16* RWL = (const bf16*)(ws + WS_RWL);
    int* toke = (int*)(ws + WS_TOKE); float* tokw = (float*)(ws + WS_TOKW); int* tokp = (int*)(ws + WS_TOKP); int* rowtok = (int*)(ws + WS_ROWTOK);
    unsigned* cnt = (unsigned*)(ws + WS_CTL) + CW_CNT + l * 32;
    LAS unsigned* hist = (LAS unsigned*)(lds + MISC_OFF + MO_HIST); LAS unsigned* base = (LAS unsigned*)(lds + MISC_OFF + MO_BASE);
    LAS int* pe = (LAS int*)(lds + MISC_OFF + MO_PE); LAS int* pr = (LAS int*)(lds + MISC_OFF + MO_PR);
    for (int panel = vcu; panel < T / 256; panel += G) {
        if (tid < 32) hist[tid] = 0u;
        for (int bt = 0; bt < 8; ++bt) {
            const int row0 = panel * 256 + wave * 32 + bt * 4;
#pragma unroll
            for (int r = 0; r < 4; ++r) {
                const bf16* zr = Z + (size_t)(row0 + r) * 1024; const u32x4 w0 = *(const u32x4*)(zr + 8 * lane), w1 = *(const u32x4*)(zr + 512 + 8 * lane);
                float v[16] = {bflo(w0.x), bfhi(w0.x), bflo(w0.y), bfhi(w0.y), bflo(w0.z), bfhi(w0.z), bflo(w0.w), bfhi(w0.w), bflo(w1.x), bfhi(w1.x), bflo(w1.y), bfhi(w1.y), bflo(w1.z), bfhi(w1.z), bflo(w1.w), bfhi(w1.w)};
                float s = 0.f;
#pragma unroll
                for (int j = 0; j < 16; ++j) s += v[j];
                const float mu = wave_sum(s) * (1.0f / 1024.0f); float q2 = 0.f;
#pragma unroll
                for (int j = 0; j < 16; ++j) { v[j] -= mu; q2 += v[j] * v[j]; }
                const float rstd = rsqrtf(wave_sum(q2) * (1.0f / 1024.0f) + LN_EPS);
                float y[16];
#pragma unroll
                for (int hf = 0; hf < 2; ++hf) { const int eo = hf * 512 + 8 * lane; const f32x4 g0 = *(const f32x4*)(gain + eo), g1 = *(const f32x4*)(gain + eo + 4), b0 = *(const f32x4*)(bias + eo), b1 = *(const f32x4*)(bias + eo + 4);
#pragma unroll
                    for (int j = 0; j < 4; ++j) { y[hf * 8 + j] = v[hf * 8 + j] * rstd * g0[j] + b0[j]; y[hf * 8 + 4 + j] = v[hf * 8 + 4 + j] * rstd * g1[j] + b1[j]; } }
                bf16* xr = XB + (size_t)(row0 + r) * 1024;
                u32x4 o0, o1; o0.x = pk2(y[0], y[1]); o0.y = pk2(y[2], y[3]); o0.z = pk2(y[4], y[5]); o0.w = pk2(y[6], y[7]);
                o1.x = pk2(y[8], y[9]); o1.y = pk2(y[10], y[11]); o1.z = pk2(y[12], y[13]); o1.w = pk2(y[14], y[15]);
                *(u32x4*)(xr + 8 * lane) = o0; *(u32x4*)(xr + 512 + 8 * lane) = o1;
                quant_row(ws, row0 + r, y, lane);
            }
        }
        f32x16 acc = f32x16{};
        const bf16* yrow = XB + (size_t)(panel * 256 + wave * 32 + r32) * 1024 + hi * 8;
        for (int half = 0; half < 2; ++half) {
            __syncthreads();
            for (int i = tid; i < 2 * 32 * 64; i += 512) { const int which = i >> 11, row = (i >> 6) & 31, pc = i & 63;
                *(LAS u32x4*)(lds + which * (32 * RW_ROW) + row * RW_ROW + pc * 16) = *(const u32x4*)((which ? RWL : RWH) + (size_t)row * 1024 + half * 512 + pc * 8); }
            __syncthreads();
#pragma unroll 8
            for (int s = 0; s < 32; ++s) {
                const bf16x8 yf = *(const bf16x8*)(yrow + half * 512 + s * 16);
                const bf16x8 ah = *(const LAS bf16x8*)(lds + r32 * RW_ROW + s * 32 + hi * 16), al = *(const LAS bf16x8*)(lds + 32 * RW_ROW + r32 * RW_ROW + s * 32 + hi * 16);
                acc = __builtin_amdgcn_mfma_f32_32x32x16_bf16(ah, yf, acc, 0, 0, 0);
                acc = __builtin_amdgcn_mfma_f32_32x32x16_bf16(al, yf, acc, 0, 0, 0);
            }
        }
        {
            const int t = panel * 256 + wave * 32 + r32;
            float sc[16], bz[16];
#pragma unroll
            for (int r = 0; r < 16; ++r) { sc[r] = 1.0f / (1.0f + __expf(-acc[r])); bz[r] = sc[r] + rbias[(r & 3) + 8 * (r >> 2) + 4 * hi]; }
            float best = -1e30f; int bk = 0;
#pragma unroll
            for (int k = 0; k < 4; ++k) { float m1 = -1e30f, m2 = -1e30f;
#pragma unroll
                for (int j = 0; j < 4; ++j) { const float v = bz[4 * k + j]; if (v > m1) { m2 = m1; m1 = v; } else if (v > m2) m2 = v; }
                const float gs = m1 + m2; if (gs > best) { best = gs; bk = k; } }
            const int gid = 2 * bk + hi; const float pbest = __shfl_xor(best, 32); const int pgid = __shfl_xor(gid, 32);
            const bool win = (best > pbest) || (best == pbest && gid < pgid);
            if (win) {
                float v0 = -1e30f, v1 = -1e30f, s0 = 0.f, s1 = 0.f; int i0 = 0, i1 = 0;
#pragma unroll
                for (int k = 0; k < 4; ++k) if (k == bk) {
#pragma unroll
                    for (int j = 0; j < 4; ++j) { const float v = bz[4 * k + j], s = sc[4 * k + j]; const int e = 8 * k + 4 * hi + j;
                        if (v > v0) { v1 = v0; i1 = i0; s1 = s0; v0 = v; i0 = e; s0 = s; } else if (v > v1) { v1 = v; i1 = e; s1 = s; } } }
                const float inv = 1.0f / (s0 + s1);
                toke[t * 2] = i0; toke[t * 2 + 1] = i1; tokw[t * 2] = s0 * inv; tokw[t * 2 + 1] = s1 * inv;
                const int tl = (t & 255) * 2; pe[tl] = i0; pe[tl + 1] = i1; pr[tl] = (int)atomicAdd((unsigned*)&hist[i0], 1u); pr[tl + 1] = (int)atomicAdd((unsigned*)&hist[i1], 1u);
            }
        }
        __syncthreads();
        if (tid < 32) base[tid] = atomicAdd(cnt + tid, hist[tid]);
        __syncthreads();
        { const int e = pe[tid], pos = pr[tid] + (int)base[e]; tokp[panel * 512 + tid] = pos; const int tk = panel * 256 + (tid >> 1); rowtok[(size_t)e * ECAP + pos] = tk + (tk >= XQ_SPLIT * 256 ? XQ_VOFF : 0); }
        __syncthreads();
    }
}
__device__ __forceinline__ void moe_tables(PT pt, int l, LAS uchar* lds) {
    LAS int* pads = (LAS int*)(lds + MISC_OFF + MO_PADS); LAS int* mts = (LAS int*)(lds + MISC_OFF + MO_MTS);
    if (threadIdx.x == 0) { const unsigned* cnt = (const unsigned*)(((uchar*)ldptr(pt, I_WS)) + WS_CTL) + CW_CNT + l * 32; int acc = 0;
        for (int e = 0; e < 32; ++e) { mts[e] = acc; pads[e] = acc * 256; acc += (int)((cnt[e] + 255u) >> 8); } mts[32] = acc; pads[32] = acc * 256; }
    __syncthreads();
}
struct MoeSched {
    int G, c; const LAS int* mts; const char* Ab; size_t a_tile; const char* Wb; size_t w_exp, w_nt; const int* rowtok; int c_step;
    __device__ __forceinline__ bool next(int i, pg8::Unit& u) const {
        const int L = i * G + c; const int MT = __builtin_amdgcn_readfirstlane(mts[32]); if (L >= MT * 4) return false;
        const int mt = L >> 2, nt = L & 3; int e = 0;
        for (int j = 1; j < 32; ++j) e += (mt >= mts[j]) ? 1 : 0;
        e = __builtin_amdgcn_readfirstlane(e);
        u.A = Ab + (size_t)mt * a_tile; u.B = Wb + (size_t)e * w_exp + (size_t)nt * w_nt; u.rows = rowtok + (size_t)e * ECAP + (mt - __builtin_amdgcn_readfirstlane(mts[e])) * 256; u.r0 = mt * 256; u.c0 = nt * c_step; u.aux = e; return true;
    }
};
__device__ __forceinline__ void ln2_phase(PT pt, int l, LAS uchar* lds, int vcu, int G) {
    moe_tables(pt, l, lds);
    const LAS int* pads = (const LAS int*)(lds + MISC_OFF + MO_PADS);
    const int tid = ltid(), lane = tid & 63, wave = __builtin_amdgcn_readfirstlane(tid >> 6);
    uchar* ws = (uchar*)ldptr(pt, I_WS); bf16* XB = (bf16*)(ws + WS_XB); const uchar* YB = (const uchar*)(ws + WS_YB);
    const int* toke = (const int*)(ws + WS_TOKE); const int* tokp = (const int*)(ws + WS_TOKP); const float* tokw = (const float*)(ws + WS_TOKW);
    const float* gain = (const float*)ldptr(pt, I_LNG) + (size_t)(l * 2 + 1) * 1024; const float* bias = (const float*)ldptr(pt, I_LNB) + (size_t)(l * 2 + 1) * 1024;
    float gn[16], bs[16];
#pragma unroll
    for (int j = 0; j < 16; ++j) { const int e = (j < 8) ? 8 * lane + j : 512 + 8 * lane + (j - 8); gn[j] = gain[e]; bs[j] = bias[e]; }
    for (int tb = vcu * 8 + wave; tb < T; tb += G * 8 * 64) {
        const int tj = tb + lane * G * 8; int sl0 = 0, sl1 = 0; float wl0 = 0.f, wl1 = 0.f;
        if (tj < T) { sl0 = pads[toke[tj * 2]] + tokp[tj * 2]; sl1 = pads[toke[tj * 2 + 1]] + tokp[tj * 2 + 1]; wl0 = tokw[tj * 2]; wl1 = tokw[tj * 2 + 1]; }
      for (int j = 0; j < 64; ++j) { const int t = tb + j * G * 8; if (t >= T) break;
        const int s0 = __builtin_amdgcn_readlane(sl0, j), s1 = __builtin_amdgcn_readlane(sl1, j); const float w0 = __builtin_bit_cast(float, __builtin_amdgcn_readlane(__builtin_bit_cast(int, wl0), j)), w1 = __builtin_bit_cast(float, __builtin_amdgcn_readlane(__builtin_bit_cast(int, wl1), j));
        float v[16];
#pragma unroll
        for (int hf = 0; hf < 2; ++hf) { const int off = hf * 512 + 8 * lane;
            const u32x4 xw = *(const u32x4*)(XB + (size_t)t * 1024 + off); const u32x2 ya = *(const u32x2*)(YB + (size_t)s0 * 1024 + off), yb = *(const u32x2*)(YB + (size_t)s1 * 1024 + off);
            const unsigned xs[4] = {xw.x, xw.y, xw.z, xw.w}; const int as[2] = {(int)ya.x, (int)ya.y}, bs_[2] = {(int)yb.x, (int)yb.y};
            const f32x2 fa[4] = {__builtin_amdgcn_cvt_pk_f32_fp8(as[0], false), __builtin_amdgcn_cvt_pk_f32_fp8(as[0], true), __builtin_amdgcn_cvt_pk_f32_fp8(as[1], false), __builtin_amdgcn_cvt_pk_f32_fp8(as[1], true)};
            const f32x2 fb[4] = {__builtin_amdgcn_cvt_pk_f32_fp8(bs_[0], false), __builtin_amdgcn_cvt_pk_f32_fp8(bs_[0], true), __builtin_amdgcn_cvt_pk_f32_fp8(bs_[1], false), __builtin_amdgcn_cvt_pk_f32_fp8(bs_[1], true)};
#pragma unroll
            for (int j = 0; j < 4; ++j) { v[hf * 8 + 2 * j] = DN_ALPHA * bflo(xs[j]) + w0 * fa[j][0] + w1 * fb[j][0]; v[hf * 8 + 2 * j + 1] = DN_ALPHA * bfhi(xs[j]) + w0 * fa[j][1] + w1 * fb[j][1]; } }
        float s = 0.f;
#pragma unroll
        for (int j = 0; j < 16; ++j) s += v[j];
        const float mu = wave_sum(s) * (1.0f / 1024.0f); float q = 0.f;
#pragma unroll
        for (int j = 0; j < 16; ++j) { v[j] -= mu; q += v[j] * v[j]; }
        const float rstd = rsqrtf(wave_sum(q) * (1.0f / 1024.0f) + LN_EPS);
#pragma unroll
        for (int j = 0; j < 16; ++j) v[j] = v[j] * rstd * gn[j] + bs[j];
        if (l == DEPTH - 1) { float* orow = ((float*)ldptr(pt, I_OUT)) + (size_t)t * 1024;
            *(f32x4*)(orow + 8 * lane) = (f32x4){v[0], v[1], v[2], v[3]}; *(f32x4*)(orow + 8 * lane + 4) = (f32x4){v[4], v[5], v[6], v[7]};
            *(f32x4*)(orow + 512 + 8 * lane) = (f32x4){v[8], v[9], v[10], v[11]}; *(f32x4*)(orow + 512 + 8 * lane + 4) = (f32x4){v[12], v[13], v[14], v[15]}; }
        else quant_row(ws, t, v, lane);
      }
    }
}
constexpr int NPH = 13;
#ifndef PHMASK
#define PHMASK 0x1fff
#endif
#ifndef SUB
#define SUB 7
#endif
#ifndef STAGGER_N
#define STAGGER_N 2
#endif
#ifndef MK_PER_PHASE
#define MK_PER_PHASE 0
#endif
__global__ void __launch_bounds__(512, 2) mk_fwd(Args args, int p_lo, int p_hi, int li) {
    extern __shared__ __attribute__((aligned(16))) uchar lds_raw[];
    LAS uchar* lds = (LAS uchar*)lds_raw;
    const int tid = threadIdx.x;
    const int G = gridDim.x, bx = blockIdx.x;
    const int vcu = (G % 8 == 0) ? (bx % 8) * (G / 8) + bx / 8 : bx;
    for (int u = tid; u < (LDS_BYTES - MISC_OFF) / 4; u += 512) ((LAS unsigned*)(lds + MISC_OFF))[u] = 0u;
    __syncthreads();
    if (tid == 0) { LAS unsigned long long* w = (LAS unsigned long long*)(lds + MISC_OFF + MO_PTAB);
#pragma unroll
        for (int k = 0; k < 29; ++k) w[k] = (unsigned long long)args.in[k];
        w[I_OUT] = (unsigned long long)args.out; w[I_WS] = (unsigned long long)args.ws; }
    __syncthreads();
    XcdBarrier bar = xcd_barrier_post((unsigned*)(args.ws + WS_CTL) + CW_BAR + li * XCD_BAR_WORDS, (volatile LAS unsigned*)(lds + MISC_OFF + MO_BAR));
    PT pt = (PT)(lds + MISC_OFF + MO_PTAB);
#define IN(P) (p_lo <= (P) && (P) < p_hi)
#define PH_BEGIN asm volatile("" ::: "memory"); uchar* ws = (uchar*)ldptr(pt, I_WS); float* ssq = (float*)(ws + WS_SSQ); (void)ssq
#define STAGGER() do { if (bx & 1) { for (int _i = 0; _i < STAGGER_N; ++_i) __builtin_amdgcn_s_sleep(127); } } while (0)
#define SEAM(P) do { if (IN((P) + 1)) xcd_barrier(bar); } while (0)
    for (int l = 0; l < DEPTH; ++l) {
        const int P0 = l * NPH;
        if (((PHMASK >> 0) & 1) && IN(P0 + 0)) { PH_BEGIN; if (l == 0) { prep_phase(pt, 0, lds, vcu, G); moe_colmax_pass(pt, 0, vcu, G);
            { int* rt = (int*)(ws + WS_ROWTOK); for (size_t i = (size_t)vcu * 512 + ltid(); i < (size_t)32 * ECAP; i += (size_t)G * 512) rt[i] = 0; }
            SEAM(P0 + 0); } }
        if (((PHMASK >> 1) & 1) && IN(P0 + 1)) { PH_BEGIN;
            pg8::SplitSched S; S.base.init(T / 256, 10, G, bx, ws + WS_XQ1, (size_t)256 * 1024, ws + W_IN, (size_t)256 * 1024); S.A2 = (const char*)(ws + WS_XQ2); S.split = XQ_SPLIT; S.a_step = (size_t)256 * 1024;
            epi::InProj8 E{{(bf16*)(ws + WS_U1), (bf16*)(ws + WS_UC), (bf16*)(ws + WS_KV), ssq, (const f32x2*)(ws + WS_ROPEA), (const f32x2*)(ws + WS_ROPEB), 0.17677669529663687f * LOG2E}, (const float*)(ws + WS_XRS), (const float*)(ws + WS_ICS)};
            pg8::gemm_phase<epi::InProj8, pg8::SplitSched, false, false, false, true>(lds, 512, 512, S, E);
            SEAM(P0 + 1);
        }
        if (((PHMASK >> 2) & 1) && IN(P0 + 2)) { PH_BEGIN;
            if (SUB & 1) { pg8::GridSched S; S.init(T / 256, 3, G, bx, ws + WS_U1 + 1536 * 2, (size_t)256 * U1_LD * 2, ws + W_UQ, (size_t)256 * 256 * 2);
              epi::QUp E{(bf16*)(ws + WS_Q), ssq, (const f32x2*)(ws + WS_ROPEA), 0.10206207261596577f * LOG2E};
              pg8::gemm_phase<epi::QUp, pg8::GridSched, false>(lds, 256, U1_LD, S, E); }
            if (SUB & 2) { pg8::GridSched S; S.init(T / 256, 4, G, bx, ws + WS_U1 + 1792 * 2, (size_t)256 * U1_LD * 2, ws + W_UKV, (size_t)256 * 128 * 2);
              epi::KVUp E{(bf16*)(ws + WS_KV), ssq};
              pg8::gemm_phase<epi::KVUp, pg8::GridSched, false>(lds, 128, U1_LD, S, E); }
            if (SUB & 4) { pg8::GridSched S; S.init(512, 1, G, bx, ws + WS_UC, (size_t)256 * UC_LD * 2, ws + W_SS, 0, 16, (size_t)256 * 256 * 2);
              epi::SsmS E{(bf16*)(ws + WS_S)};
              pg8::gemm_phase<epi::SsmS, pg8::GridSched, false>(lds, 256, UC_LD, S, E); }
            SEAM(P0 + 2);
        }
        if (((PHMASK >> 3) & 1) && IN(P0 + 3)) { PH_BEGIN; scan_phase(pt, vcu, G); attn_phase(pt, l, lds, bx, G, vcu); SEAM(P0 + 3); }
        if (((PHMASK >> 4) & 1) && IN(P0 + 4)) { PH_BEGIN;
            if (SUB & 1) { pg8::SplitSched S; S.base.init(T / 256, 12, G, bx, ws + WS_XQ1, (size_t)256 * 1024, ws + W_G, (size_t)256 * 1024); S.A2 = (const char*)(ws + WS_XQ2); S.split = XQ_SPLIT; S.a_step = (size_t)256 * 1024;
              epi::Gate8 E{(uchar*)(ws + WS_G), (const float*)ldptr(pt, I_BGATE) + l * 3072, (const float*)(ws + WS_XRS), (const float*)(ws + WS_GCS)};
              pg8::gemm_phase<epi::Gate8, pg8::SplitSched, false, false, false, true>(lds, 512, 512, S, E); }
            if (SUB & 2) { pg8::GridSched S; S.init(512, 1, G, bx, ws + WS_UC, (size_t)256 * UC_LD * 2, ws + W_SY, 0, 16, (size_t)256 * 384 * 2);
              epi::SsmY E{(const bf16*)(ws + WS_UC), (bf16*)(ws + WS_O3), (const float*)ldptr(pt, I_SSMD) + l * 512};
              pg8::gemm_phase<epi::SsmY, pg8::GridSched, false>(lds, 384, UC_LD, S, E); }
            SEAM(P0 + 4);
        }
        if (((PHMASK >> 5) & 1) && IN(P0 + 5)) { PH_BEGIN;
            pg8::TriSched S; S.base.init(T / 256, 4, G, bx, ws + WS_O3, (size_t)256 * O3_LD * 2, ws + W_A, (size_t)256 * 1024 * 2); S.Bglu = (const char*)(ws + W_GLU2);
            epi::GluAB E{{(bf16*)(ws + WS_MG), (const uchar*)(ws + WS_G)}, {(bf16*)(ws + WS_MG), (const uchar*)(ws + WS_G)}};
            pg8::gemm_phase<epi::GluAB, pg8::TriSched, false, true, true>(lds, 1024, O3_LD, S, E);
            SEAM(P0 + 5);
        }
        if (((PHMASK >> 7) & 1) && IN(P0 + 7)) { PH_BEGIN;
            pg8::GridSched S; S.init(T / 256, 4, G, bx, ws + WS_MG, (size_t)256 * 1024 * 2, ws + W_O, (size_t)256 * 1024 * 2);
            epi::OutProj E{(bf16*)(ws + WS_Z), ws + WS_XQ1, ws + WS_XQ2, (const float*)(ws + WS_XRS)};
            pg8::gemm_phase<epi::OutProj, pg8::GridSched, false>(lds, 1024, 1024, S, E);
            SEAM(P0 + 7);
        }
        if (((PHMASK >> 8) & 1) && IN(P0 + 8)) { PH_BEGIN; ln1_router_phase(pt, l, lds, vcu, G); SEAM(P0 + 8); }
        if (((PHMASK >> 10) & 1) && IN(P0 + 10)) { PH_BEGIN;
            moe_tables(pt, l, lds);
            MoeSched S{G, vcu, (const LAS int*)(lds + MISC_OFF + MO_MTS), (const char*)(ws + WS_XQ1), 0, (const char*)(ws + WS_WM1), (size_t)1024 * 1024, (size_t)256 * 1024, (const int*)(ws + WS_ROWTOK), 128};
            epi::Moe1_8 E{(bf16*)(ws + WS_H), (const float*)(ws + WS_XRS), (const float*)(ws + WS_MCM) + (size_t)l * 32 * 1024};
            pg8::gemm_phase<epi::Moe1_8, MoeSched, true, false, false, true>(lds, 512, 512, S, E);
            if (l + 1 < DEPTH) {
                const int nun = __builtin_amdgcn_readfirstlane(((const LAS int*)(lds + MISC_OFF + MO_MTS))[32]) * 4, rem = nun % G;
                __syncthreads();
                if (vcu >= rem) prep_phase(pt, l + 1, lds, vcu - rem, G - rem);
            }
            SEAM(P0 + 10);
        }
        if (((PHMASK >> 11) & 1) && IN(P0 + 11)) { PH_BEGIN;
            moe_tables(pt, l, lds);
            MoeSched S{G, vcu, (const LAS int*)(lds + MISC_OFF + MO_MTS), (const char*)(ws + WS_H), (size_t)256 * 512 * 2, (const char*)(ws + WS_WM2), (size_t)1024 * 512 * 2, (size_t)256 * 512 * 2, (const int*)(ws + WS_ROWTOK), 256};
            epi::Moe2 E{(uchar*)(ws + WS_YB)};
            pg8::gemm_phase<epi::Moe2, MoeSched, false>(lds, 512, 512, S, E);
            SEAM(P0 + 11);
        }
        if (((PHMASK >> 12) & 1) && IN(P0 + 12)) { PH_BEGIN; ln2_phase(pt, l, lds, vcu, G); if (l + 1 < DEPTH) SEAM(P0 + 12); }
    }
#undef IN
#undef SEAM
}

__global__ void dbg_dump(const bf16* src, int ld, int col0, float* out) {
    for (size_t i = (size_t)blockIdx.x * 256 + threadIdx.x; i < (size_t)T * 1024; i += (size_t)gridDim.x * 256) { const size_t t = i >> 10; const int c = (int)(i & 1023); out[i] = __uint_as_float(((unsigned)src[t * ld + col0 + c]) << 16); }
}
extern "C" void kernel_launch(void* const* d_in, const int* in_sizes, int n_in, void* d_out, int out_size, void* d_ws, size_t ws_size, hipStream_t stream) {
    static int grid = 0;
    if (grid == 0) {
        if (n_in != 29 || in_sizes[0] != T * D_MODEL || out_size != T * D_MODEL || ws_size < WS_END) { fprintf(stderr, "kernel_launch: unexpected shapes / workspace (%d inputs, ws %zu < %zu)\n", n_in, ws_size, (size_t)WS_END); grid = -1; return; }
        int dev = 0, cus = 0, per_cu = 0;
        if (hipGetDevice(&dev) != hipSuccess || hipDeviceGetAttribute(&cus, hipDeviceAttributeMultiprocessorCount, dev) != hipSuccess) { grid = -1; return; }
        if (hipFuncSetAttribute((const void*)mk_fwd, hipFuncAttributeMaxDynamicSharedMemorySize, LDS_BYTES) != hipSuccess) { fprintf(stderr, "kernel_launch: hipFuncSetAttribute failed\n"); grid = -1; return; }
        if (hipOccupancyMaxActiveBlocksPerMultiprocessor(&per_cu, (const void*)mk_fwd, 512, LDS_BYTES) != hipSuccess || per_cu < 1) fprintf(stderr, "kernel_launch: occupancy query reports %d\n", per_cu);
        (void)hipGetLastError();
        grid = cus;
    }
    if (grid < 0) return;
    if (hipMemsetAsync((char*)d_ws + WS_CTL, 0, WS_ZERO_BYTES, stream) != hipSuccess) return;
    Args a{};
    for (int i = 0; i < 29; ++i) a.in[i] = d_in[i];
    a.out = (float*)d_out; a.ws = (uchar*)d_ws;
#if defined(DBG_STOP)
    for (int p = 0; p < DBG_STOP; ++p) hipLaunchKernelGGL(mk_fwd, dim3(grid), dim3(512), LDS_BYTES, stream, a, p, p + 1, 0);
    hipLaunchKernelGGL(dbg_dump, dim3(4096), dim3(256), 0, stream, (const bf16*)((const uchar*)d_ws + (DBG_OFF)), (int)(DBG_LD), (int)(DBG_COL), (float*)d_out);
#elif MK_PER_PHASE
    for (int p = 0; p < DEPTH * NPH; ++p) hipLaunchKernelGGL(mk_fwd, dim3(grid), dim3(512), LDS_BYTES, stream, a, p, p + 1, 0);
#else
    hipLaunchKernelGGL(mk_fwd, dim3(grid), dim3(512), LDS_BYTES, stream, a, 0, DEPTH * NPH, 0);
#if defined(PROBE_PH)
    for (int rep = 0; rep < 4; ++rep) for (int k = 0; k < NPH - 1; ++k) if ((PROBE_PH >> k) & 1) hipLaunchKernelGGL(mk_fwd, dim3(grid), dim3(512), LDS_BYTES, stream, a, 3 * NPH + k, 3 * NPH + k + 1, 1);
#endif
#endif
}
```
